# Optimizing an MI355X kernel written in HIP

```python
import math
import jax, jax.numpy as jnp
from jax import lax
import numpy as np

D_MODEL = 1024
BATCH = 2
SEQ = 16384
DEPTH = 1
DEC_BATCH = 16
DEC_SEQ = 64
PAST_LEN = 2048

CHUNK = 64
N_HEADS = 8
QK_NOPE = 64
ROPE_DIM = 32
HEAD_DIM = QK_NOPE + ROPE_DIM
V_DIM = 64
Q_LORA = 384
KV_LORA = 256
ATT_WIDTH = N_HEADS * V_DIM
CONV_CH = D_MODEL // 2
CONV_K = 31
MIX_WIDTH = ATT_WIDTH + CONV_CH
IN_WIDTH = Q_LORA + KV_LORA + ROPE_DIM + 2 * CONV_CH
D_FF = 2816
FFN_K = 3
Q_BLOCK = 128
ROPE_BASE = 10000.0
RMS_EPS = 1e-6
NEG_INF = -1e30
SCALE = HEAD_DIM ** -0.5

kernel_name = "mla_conformer_conv_hybrid_stream_step"


def _rms(x, g):
    xf = x.astype(jnp.float32)
    y = xf * lax.rsqrt(jnp.mean(xf * xf, axis=-1, keepdims=True) + RMS_EPS)
    return (y * g.astype(jnp.float32)).astype(x.dtype)


def _rope_tail(x, pos):
    nope, pe = x[..., :QK_NOPE], x[..., QK_NOPE:]
    inv = 1.0 / (ROPE_BASE ** (jnp.arange(0, ROPE_DIM, 2, dtype=jnp.float32) / ROPE_DIM))
    ang = pos.astype(jnp.float32)[:, None] * inv[None, :]
    cos = jnp.cos(ang)[None, :, None, :].astype(x.dtype)
    sin = jnp.sin(ang)[None, :, None, :].astype(x.dtype)
    p1, p2 = pe[..., :ROPE_DIM // 2], pe[..., ROPE_DIM // 2:]
    return jnp.concatenate([nope, p1 * cos - p2 * sin, p2 * cos + p1 * sin], axis=-1)


def _attend_block(q, k, v, q_pos, k_pos):
    s = jnp.einsum('bqhd,bkhd->bhqk', q, k).astype(jnp.float32) * SCALE
    allowed = (k_pos // CHUNK)[None, :] <= (q_pos // CHUNK)[:, None]
    s = jnp.where(allowed[None, None], s, NEG_INF)
    p = jax.nn.softmax(s, axis=-1).astype(v.dtype)
    return jnp.einsum('bhqk,bkhd->bqhd', p, v)


def _chunk_causal_attention(q, k, v, q_pos, k_pos):
    B, T, H, dh = q.shape
    if T % Q_BLOCK == 0:
        nb = T // Q_BLOCK
        qb = q.reshape(B, nb, Q_BLOCK, H, dh).transpose(1, 0, 2, 3, 4)
        pb = q_pos.reshape(nb, Q_BLOCK)
        out = lax.map(lambda a: _attend_block(a[0], k, v, a[1], k_pos), (qb, pb))
        out = out.transpose(1, 0, 2, 3, 4)
    else:
        out = _attend_block(q, k, v, q_pos, k_pos)
    return out.reshape(B, T, H * V_DIM)


def _causal_dwconv(x_all, w, b):
    C = x_all.shape[-1]
    y = lax.conv_general_dilated(
        x_all, w[:, None, :], window_strides=(1,), padding='VALID',
        dimension_numbers=('NWC', 'WIO', 'NWC'), feature_group_count=C)
    return y + b


def _layer(x, ckv_past, kpe_past, conv_past, ffn_past,
           attn_norm, w_in, q_norm, w_uq, kv_norm, w_ukv, qk_norm_q, qk_norm_k,
           conv_w, conv_b, conv_norm, w_out, ffn_norm, w_up, ffn_conv_w, ffn_conv_b, w_down):
    B, T, _ = x.shape
    pos0 = ckv_past.shape[1]
    h = _rms(x, attn_norm)
    proj = h @ w_in
    c_q = proj[..., :Q_LORA]
    c_kv = _rms(proj[..., Q_LORA:Q_LORA + KV_LORA], kv_norm)
    k_pe = proj[..., Q_LORA + KV_LORA:Q_LORA + KV_LORA + ROPE_DIM]
    glu = proj[..., Q_LORA + KV_LORA + ROPE_DIM:]

    q = (_rms(c_q, q_norm) @ w_uq).reshape(B, T, N_HEADS, HEAD_DIM)
    ckv_all = jnp.concatenate([ckv_past, c_kv], axis=1)
    kpe_all = jnp.concatenate([kpe_past, k_pe], axis=1)
    Tk = ckv_all.shape[1]
    kv = (ckv_all @ w_ukv).reshape(B, Tk, N_HEADS, QK_NOPE + V_DIM)
    k_nope, v = kv[..., :QK_NOPE], kv[..., QK_NOPE:]
    k = jnp.concatenate(
        [k_nope, jnp.broadcast_to(kpe_all[:, :, None, :], (B, Tk, N_HEADS, ROPE_DIM))], axis=-1)
    q_pos = pos0 + jnp.arange(T, dtype=jnp.int32)
    k_pos = jnp.arange(Tk, dtype=jnp.int32)
    q = _rope_tail(_rms(q, qk_norm_q), q_pos)
    k = _rope_tail(_rms(k, qk_norm_k), k_pos)
    att = _chunk_causal_attention(q, k, v, q_pos, k_pos)

    u = glu[..., :CONV_CH] * jax.nn.sigmoid(glu[..., CONV_CH:])
    u_all = jnp.concatenate([conv_past, u], axis=1)
    c = jax.nn.silu(_rms(_causal_dwconv(u_all, conv_w, conv_b), conv_norm))

    x = x + jnp.concatenate([att, c], axis=-1) @ w_out

    up = _rms(x, ffn_norm) @ w_up
    a, gate = up[..., :D_FF], up[..., D_FF:]
    a_all = jnp.concatenate([ffn_past, a], axis=1)
    a = _causal_dwconv(a_all, ffn_conv_w, ffn_conv_b)
    y = x + (jax.nn.silu(a) * gate) @ w_down

    return y, c_kv, k_pe, u_all[:, -(CONV_K - 1):], a_all[:, -(FFN_K - 1):]


def setup_inputs(seed: int = 0) -> dict:
    key = jax.random.key(seed)
    ks = jax.random.split(key, 24)
    f32 = jnp.float32
    nrm = lambda k, shape, s: jax.random.normal(k, shape, f32) * s
    gain = lambda k, n: 1.0 + 0.01 * jax.random.normal(k, (DEPTH, n), f32)
    return {
        "x_prompt": nrm(ks[0], (BATCH, SEQ, D_MODEL), 1.0),
        "x_sample": nrm(ks[1], (DEC_BATCH, DEC_SEQ, D_MODEL), 1.0),
        "cache_ckv": nrm(ks[2], (DEPTH, DEC_BATCH, PAST_LEN, KV_LORA), 1.0),
        "cache_kpe": nrm(ks[3], (DEPTH, DEC_BATCH, PAST_LEN, ROPE_DIM), 0.5),
        "state_conv": nrm(ks[4], (DEPTH, DEC_BATCH, CONV_K - 1, CONV_CH), 0.5),
        "state_ffn_conv": nrm(ks[5], (DEPTH, DEC_BATCH, FFN_K - 1, D_FF), 0.5),
        "attn_norm": gain(ks[6], D_MODEL),
        "w_in": nrm(ks[7], (DEPTH, D_MODEL, IN_WIDTH), D_MODEL ** -0.5),
        "q_norm": gain(ks[8], Q_LORA),
        "w_uq": nrm(ks[9], (DEPTH, Q_LORA, N_HEADS * HEAD_DIM), Q_LORA ** -0.5),
        "kv_norm": gain(ks[10], KV_LORA),
        "w_ukv": nrm(ks[11], (DEPTH, KV_LORA, N_HEADS * (QK_NOPE + V_DIM)), KV_LORA ** -0.5),
        "qk_norm_q": gain(ks[12], HEAD_DIM),
        "qk_norm_k": gain(ks[13], HEAD_DIM),
        "conv_w": nrm(ks[14], (DEPTH, CONV_K, CONV_CH), CONV_K ** -0.5),
        "conv_b": nrm(ks[15], (DEPTH, CONV_CH), 0.01),
        "conv_norm": gain(ks[16], CONV_CH),
        "w_out": nrm(ks[17], (DEPTH, MIX_WIDTH, D_MODEL), MIX_WIDTH ** -0.5),
        "ffn_norm": gain(ks[18], D_MODEL),
        "w_up": nrm(ks[19], (DEPTH, D_MODEL, 2 * D_FF), D_MODEL ** -0.5),
        "ffn_conv_w": nrm(ks[20], (DEPTH, FFN_K, D_FF), FFN_K ** -0.5),
        "ffn_conv_b": nrm(ks[21], (DEPTH, D_FF), 0.01),
        "w_down": nrm(ks[22], (DEPTH, D_FF, D_MODEL), D_FF ** -0.5),
    }


def reference(x_prompt, x_sample, cache_ckv, cache_kpe, state_conv, state_ffn_conv,
              attn_norm, w_in, q_norm, w_uq, kv_norm, w_ukv, qk_norm_q, qk_norm_k,
              conv_w, conv_b, conv_norm, w_out, ffn_norm, w_up, ffn_conv_w, ffn_conv_b, w_down):
    B = x_prompt.shape[0]
    dt = x_prompt.dtype
    yp, ys = x_prompt, x_sample
    p_ckv, p_kpe, p_conv, p_ffn = [], [], [], []
    s_ckv, s_kpe, s_conv, s_ffn = [], [], [], []
    for l in range(DEPTH):
        w = (attn_norm[l], w_in[l], q_norm[l], w_uq[l], kv_norm[l], w_ukv[l], qk_norm_q[l],
             qk_norm_k[l], conv_w[l], conv_b[l], conv_norm[l], w_out[l], ffn_norm[l], w_up[l],
             ffn_conv_w[l], ffn_conv_b[l], w_down[l])
        yp, c1, k1, cv1, f1 = _layer(
            yp, jnp.zeros((B, 0, KV_LORA), dt), jnp.zeros((B, 0, ROPE_DIM), dt),
            jnp.zeros((B, CONV_K - 1, CONV_CH), dt), jnp.zeros((B, FFN_K - 1, D_FF), dt), *w)
        ys, c2, k2, cv2, f2 = _layer(
            ys, cache_ckv[l], cache_kpe[l], state_conv[l], state_ffn_conv[l], *w)
        p_ckv.append(c1); p_kpe.append(k1); p_conv.append(cv1); p_ffn.append(f1)
        s_ckv.append(c2); s_kpe.append(k2); s_conv.append(cv2); s_ffn.append(f2)
    return (yp, ys,
            jnp.stack(p_ckv), jnp.stack(p_kpe), jnp.stack(p_conv), jnp.stack(p_ffn),
            jnp.stack(s_ckv), jnp.stack(s_kpe), jnp.stack(s_conv), jnp.stack(s_ffn))
```

```cpp
#include <hip/hip_runtime.h>
#include <hip/hip_cooperative_groups.h>
#include <cstdio>
#include <cstdint>
namespace cg = cooperative_groups;
namespace pg8 {
#define PG8_LAS __attribute__((address_space(3)))
typedef unsigned short bf16_t;
typedef short bf16x8 __attribute__((ext_vector_type(8)));
typedef float f32x4 __attribute__((ext_vector_type(4)));
typedef unsigned u32x4 __attribute__((ext_vector_type(4)));
constexpr int BM = 256, BK = 64, HALF = 128, HTB = HALF * BK * 2  , STAGE_BYTES = 8 * HTB, NXCD = 8, WGM = 8;

__host__ __device__ __forceinline__ int lds_byte(int r, int c) { const int st = (r >> 4) * 2 + (c >> 5), rr = r & 15, cc = c & 31, ob = rr * 64 + cc * 2; return st * 1024 + (ob ^ (((ob >> 9) & 1) << 5)); }
__host__ __device__ __forceinline__ void stage_rc(int b, int& R, int& C) { const int st = b / 1024, sb = b % 1024, swz = sb ^ (((sb >> 9) & 1) << 5); R = (st >> 1) * 16 + swz / 64; C = (st & 1) * 32 + (swz % 64) / 2; }
__host__ __device__ __forceinline__ int perm32(int rho) { const int n = rho >> 4, i = rho & 15; return 8 * (i >> 2) + 4 * n + (i & 3); }

struct Unit { int pm, pn; };
struct Gemm { const bf16_t* A; const bf16_t* Bt; int M, N, K; };

struct StaticOrder {
    int nM, nN, nwg, G, c;
    __host__ __device__ void init(int M, int N, int G_, int c_) { nM = M / BM; nN = N / BM; nwg = nM * nN; G = G_; c = c_; }
    __host__ __device__ bool next(int i, Unit& u) const {
        const long L = (long)i * G + c; if (L >= nwg) return false;
        int wgid = (int)L; { const int q = nwg / NXCD, r = nwg % NXCD, xcd = wgid % NXCD, off = wgid / NXCD; wgid = (xcd < r ? xcd * (q + 1) : r * (q + 1) + (xcd - r) * q) + off; }
        const int nig = WGM * nN, gid = wgid / nig, fm = gid * WGM, gsz = (nM - fm) < WGM ? (nM - fm) : WGM;
        u.pm = fm + ((wgid % nig) % gsz); u.pn = (wgid % nig) / gsz; return true;
    }
    __device__ __forceinline__ void a_ready(const Unit&) const {}
    __device__ __forceinline__ void done(const Unit&) const {}
};


__device__ __forceinline__ unsigned cvt_pk_bf16(float lo, float hi) { unsigned r; asm volatile("v_cvt_pk_bf16_f32 %0, %1, %2" : "=v"(r) : "v"(lo), "v"(hi)); return r; }

struct EpiBf16 {
    static constexpr bool PERM = true, AFTER_DRAIN = false;
    bf16_t* O; int ldc; int split_cols; size_t split_stride;
    __device__ __forceinline__ void operator()(const f32x4 (&acc)[2][2][4][2], const Unit& u, int wr, int wc, int fr, int fq) const {
        const int row0 = u.pm * BM + wr * 64 + fr; int colt = u.pn * BM; bf16_t* base = O;
        if (split_cols) { const int t = colt / split_cols; base += (size_t)t * split_stride; colt -= t * split_cols; }
        const int col0 = colt + wc * 32 + 8 * fq;
#pragma unroll
        for (int ai = 0; ai < 2; ++ai)
#pragma unroll
            for (int m = 0; m < 4; ++m) { bf16_t* rowp = base + (size_t)(row0 + ai * HALF + m * 16) * ldc + col0;
#pragma unroll
                for (int bj = 0; bj < 2; ++bj) { const f32x4 v0 = acc[ai][bj][m][0], v1 = acc[ai][bj][m][1];
                    u32x4 w; w.x = cvt_pk_bf16(v0[0], v0[1]); w.y = cvt_pk_bf16(v0[2], v0[3]); w.z = cvt_pk_bf16(v1[0], v1[1]); w.w = cvt_pk_bf16(v1[2], v1[3]);
                    *(u32x4*)(rowp + bj * HALF) = w; } }
    }
};

struct EpiInProj {
    static constexpr bool PERM = true, AFTER_DRAIN = false;
    float* PROJ; float* U;
    __device__ __forceinline__ void operator()(const f32x4 (&acc)[2][2][4][2], const Unit& u, int wr, int wc, int fr, int fq) const {
        const int row0 = u.pm * BM + wr * 64 + fr;
        if (u.pn < 3) {
            const int col0 = u.pn * BM + wc * 32 + 8 * fq;
#pragma unroll
            for (int ai = 0; ai < 2; ++ai)
#pragma unroll
                for (int m = 0; m < 4; ++m) { float* rowp = PROJ + (size_t)(row0 + ai * HALF + m * 16) * 768 + col0;
#pragma unroll
                    for (int bj = 0; bj < 2; ++bj) { *(f32x4*)(rowp + bj * HALF) = acc[ai][bj][m][0]; *(f32x4*)(rowp + bj * HALF + 4) = acc[ai][bj][m][1]; } }
        } else {
            const int ch0 = (u.pn - 3) * 128 + 16 * wc + 4 * fq;
#pragma unroll
            for (int ai = 0; ai < 2; ++ai)
#pragma unroll
                for (int m = 0; m < 4; ++m) { float* rowp = U + (size_t)(row0 + ai * HALF + m * 16) * 512 + ch0;
#pragma unroll
                    for (int bj = 0; bj < 2; ++bj) { const f32x4 a = acc[ai][bj][m][0], g = acc[ai][bj][m][1]; f32x4 o;
#pragma unroll
                        for (int e = 0; e < 4; ++e) o[e] = a[e] * __builtin_amdgcn_rcpf(1.f + __expf(-g[e]));
                        *(f32x4*)(rowp + bj * 64) = o; } }
        }
    }
};

struct EpiUp {
    static constexpr bool PERM = true, AFTER_DRAIN = false;
    bf16_t* H; float* AUXA; float* AUXG; const float* fw; const float* fb;
    __device__ __forceinline__ void operator()(const f32x4 (&acc)[2][2][4][2], const Unit& u, int wr, int wc, int fr, int fq) const {
        const int lane = fq * 16 + fr, src1 = (lane & 48) | ((fr + 15) & 15), src2 = (lane & 48) | ((fr + 14) & 15);
        const int ch0 = u.pn * 128 + 16 * wc + 4 * fq;
#pragma unroll
        for (int bj = 0; bj < 2; ++bj) {
            const int ch = ch0 + 64 * bj;
            const f32x4 w0 = *(const f32x4*)(fw + ch), w1 = *(const f32x4*)(fw + 2816 + ch), w2 = *(const f32x4*)(fw + 2 * 2816 + ch), bb = *(const f32x4*)(fb + ch);
#pragma unroll
            for (int ai = 0; ai < 2; ++ai) {
                const int grp = 4 * u.pm + 2 * ai + wr; const size_t row0 = (size_t)u.pm * BM + ai * HALF + wr * 64 + fr;
                f32x4 hv[4];
#pragma unroll
                for (int e = 0; e < 4; ++e) {
                    float r1[4], r2[4];
#pragma unroll
                    for (int m = 0; m < 4; ++m) { r1[m] = __shfl(acc[ai][bj][m][0][e], src1); r2[m] = __shfl(acc[ai][bj][m][0][e], src2); }
#pragma unroll
                    for (int m = 0; m < 4; ++m) {
                        const float p1 = (fr >= 1) ? r1[m] : r1[m > 0 ? m - 1 : 0], p2 = (fr >= 2) ? r2[m] : r2[m > 0 ? m - 1 : 0];
                        const float y = w0[e] * p2 + w1[e] * p1 + w2[e] * acc[ai][bj][m][0][e] + bb[e];
                        hv[m][e] = y * __builtin_amdgcn_rcpf(1.f + __expf(-y)) * acc[ai][bj][m][1][e];
                    }
                }
#pragma unroll
                for (int m = 0; m < 4; ++m) if (m > 0 || fr >= 2) {
                    unsigned lo = cvt_pk_bf16(hv[m][0], hv[m][1]), hi = cvt_pk_bf16(hv[m][2], hv[m][3]);
                    typedef unsigned u32x2 __attribute__((ext_vector_type(2)));
                    *(u32x2*)(H + (row0 + 16 * m) * 2816 + ch) = (u32x2){lo, hi};
                }
                if (fr < 2) { *(f32x4*)(AUXA + ((size_t)grp * 4 + fr) * 2816 + ch) = acc[ai][bj][0][0]; *(f32x4*)(AUXG + ((size_t)grp * 2 + fr) * 2816 + ch) = acc[ai][bj][0][1]; }
                if (fr >= 14) *(f32x4*)(AUXA + ((size_t)grp * 4 + 2 + (fr - 14)) * 2816 + ch) = acc[ai][bj][3][0];
            }
        }
    }
};

struct EpiKV {
    static constexpr bool PERM = true, AFTER_DRAIN = false;
    bf16_t* Kb; bf16_t* Vb; const float* kpe_p; const float* kpe_s; const float* kpe_past; const float* gk; const float* ropec; const float* ropes;
    __device__ __forceinline__ void operator()(const f32x4 (&acc)[2][2][4][2], const Unit& u, int wr, int wc, int fr_in, int fq_in) const {
        int fr0 = fr_in, fq0 = fq_in; asm volatile("" : "+v"(fr0), "+v"(fq0));
        const int h = 2 * u.pn + (wc >> 1);
        constexpr int TP_ = 16384, MP_ = 32768, MTOK_ = 33792, TKS_ = 2112, PAST_ = 2048; constexpr size_t KSB = (size_t)2 * 8 * TP_;
#pragma unroll
        for (int ai = 0; ai < 2; ++ai)
#pragma unroll
            for (int m = 0; m < 4; ++m) {
                int fr = fr0, fq = fq0; asm volatile("" : "+v"(fr), "+v"(fq) :: "memory");
                const int r = u.pm * BM + ai * HALF + wr * 64 + m * 16 + fr;
                size_t drow; int pos; const float* kpe;
                if (r < MP_) { const int b = r / TP_, t = r % TP_; pos = t; kpe = kpe_p + (size_t)r * 32; drow = (size_t)(b * 8 + h) * TP_ + t; }
                else if (r < MTOK_) { const int rs = r - MP_, b = rs >> 6, t = rs & 63; pos = PAST_ + t; kpe = kpe_s + (size_t)rs * 32; drow = KSB + (size_t)(b * 8 + h) * TKS_ + PAST_ + t; }
                else { const int rr = r - MTOK_, b = rr / PAST_, t = rr % PAST_; pos = t; kpe = kpe_past + (size_t)rr * 32; drow = KSB + (size_t)(b * 8 + h) * TKS_ + t; }
                if (wc & 1) {
                    bf16_t* vd = Vb + drow * 64 + 8 * fq;
#pragma unroll
                    for (int bj = 0; bj < 2; ++bj) { const f32x4 v0 = acc[ai][bj][m][0], v1 = acc[ai][bj][m][1];
                        u32x4 w; w.x = cvt_pk_bf16(v0[0], v0[1]); w.y = cvt_pk_bf16(v0[2], v0[3]); w.z = cvt_pk_bf16(v1[0], v1[1]); w.w = cvt_pk_bf16(v1[2], v1[3]);
                        *(u32x4*)(vd + 32 * bj) = w; }
                } else {
                    const f32x4 pe0 = *(const f32x4*)(kpe + 8 * fq), pe1 = *(const f32x4*)(kpe + 8 * fq + 4);
                    const f32x4 pp0 = *(const f32x4*)(kpe + 8 * (fq ^ 2)), pp1 = *(const f32x4*)(kpe + 8 * (fq ^ 2) + 4);
                    float ss = 0.f;
#pragma unroll
                    for (int bj = 0; bj < 2; ++bj)
#pragma unroll
                        for (int n = 0; n < 2; ++n)
#pragma unroll
                            for (int e = 0; e < 4; ++e) ss += acc[ai][bj][m][n][e] * acc[ai][bj][m][n][e];
#pragma unroll
                    for (int e = 0; e < 4; ++e) ss += pe0[e] * pe0[e] + pe1[e] * pe1[e];
                    ss += __shfl_xor(ss, 16); ss += __shfl_xor(ss, 32);
                    const float rstd = 1.f / sqrtf(ss * (1.f / 96.f) + 1e-6f);
                    bf16_t* kd = Kb + drow * 96 + 8 * fq;
#pragma unroll
                    for (int bj = 0; bj < 2; ++bj) { const f32x4 g0 = *(const f32x4*)(gk + 32 * bj + 8 * fq), g1 = *(const f32x4*)(gk + 32 * bj + 8 * fq + 4);
                        const f32x4 v0 = acc[ai][bj][m][0] * rstd * g0, v1 = acc[ai][bj][m][1] * rstd * g1;
                        u32x4 w; w.x = cvt_pk_bf16(v0[0], v0[1]); w.y = cvt_pk_bf16(v0[2], v0[3]); w.z = cvt_pk_bf16(v1[0], v1[1]); w.w = cvt_pk_bf16(v1[2], v1[3]);
                        *(u32x4*)(kd + 32 * bj) = w; }
                    const f32x4 ge0 = *(const f32x4*)(gk + 64 + 8 * fq), ge1 = *(const f32x4*)(gk + 64 + 8 * fq + 4);
                    const f32x4 gp0 = *(const f32x4*)(gk + 64 + 8 * (fq ^ 2)), gp1 = *(const f32x4*)(gk + 64 + 8 * (fq ^ 2) + 4);
                    const float* cs = ropec + (size_t)pos * 16 + 8 * (fq & 1); const float* sn = ropes + (size_t)pos * 16 + 8 * (fq & 1);
                    const f32x4 c0 = *(const f32x4*)cs, c1 = *(const f32x4*)(cs + 4), s0 = *(const f32x4*)sn, s1 = *(const f32x4*)(sn + 4);
                    const float sg = (fq < 2) ? -1.f : 1.f;
                    const f32x4 o0 = (pe0 * ge0 * c0 + (pp0 * gp0 * s0) * sg) * rstd, o1 = (pe1 * ge1 * c1 + (pp1 * gp1 * s1) * sg) * rstd;
                    u32x4 w; w.x = cvt_pk_bf16(o0[0], o0[1]); w.y = cvt_pk_bf16(o0[2], o0[3]); w.z = cvt_pk_bf16(o1[0], o1[1]); w.w = cvt_pk_bf16(o1[2], o1[3]);
                    *(u32x4*)(kd + 64) = w;
                }
            }
    }
};

template <bool INPLACE> struct EpiRes {
    static constexpr bool PERM = true, AFTER_DRAIN = false;
    const float* xp; const float* xs; float* out;
    __device__ __forceinline__ void operator()(const f32x4 (&acc)[2][2][4][2], const Unit& u, int wr, int wc, int fr, int fq) const {
        const int row0 = u.pm * BM + wr * 64 + fr; const int col0 = u.pn * BM + wc * 32 + 8 * fq;
        const float* rbase = INPLACE ? (const float*)out : (u.pm * BM < 32768 ? xp : xs - (size_t)32768 * 1024);
#pragma unroll
        for (int ai = 0; ai < 2; ++ai)
#pragma unroll
            for (int m = 0; m < 4; ++m) { const size_t off = (size_t)(row0 + ai * HALF + m * 16) * 1024 + col0;
#pragma unroll
                for (int bj = 0; bj < 2; ++bj) { const f32x4 r0 = *(const f32x4*)(rbase + off + bj * HALF), r1 = *(const f32x4*)(rbase + off + bj * HALF + 4);
                    *(f32x4*)(out + off + bj * HALF) = r0 + acc[ai][bj][m][0]; *(f32x4*)(out + off + bj * HALF + 4) = r1 + acc[ai][bj][m][1]; } }
    }
};

template <class Epi, class Sched, bool ALIGN_EPI = false, bool SP2 = false>
__device__ __forceinline__ void gemm_phase(PG8_LAS unsigned char* lds, const Gemm g, const Sched& S, const Epi& E) {
    int tid_ = threadIdx.x; asm volatile("" : "+v"(tid_));
    const int tid = tid_, wid = __builtin_amdgcn_readfirstlane(tid >> 6), lane = tid & 63, wr = wid >> 2, wc = wid & 3, fr = lane & 15, fq = lane >> 4;
    int K_ = g.K; asm volatile("" : "+s"(K_));
    const int K = K_, nt = K / BK;
    unsigned voffA[2], voffB[2];
#pragma unroll
    for (int i = 0; i < 2; ++i) { int R, C; stage_rc(tid * 16 + i * 8192, R, C); const int Rb = Epi::PERM ? ((R & ~31) + perm32(R & 31)) : R;
        voffA[i] = (unsigned)(R * K + C) * 2u; voffB[i] = (unsigned)(Rb * K + C) * 2u; }
    const size_t kstep = (size_t)(BK * 2);
    const size_t hstep = (size_t)HALF * K * 2;
    const size_t tstep = 2 * hstep;
    const unsigned ldsw = (unsigned)wid * 1024u;
    const int aoff = lds_byte(wr * 64 + fr, fq * 8), boff = lds_byte(wc * 32 + fr, fq * 8);
#define PG8_SA(b, h) (((b) * 2 + (h)) * HTB)
#define PG8_SB(b, h) ((4 + (b) * 2 + (h)) * HTB)
#define PG8_STAGE(bufoff, gbase, voff) do { _Pragma("unroll") for (int _i = 0; _i < 2; ++_i) \
        __builtin_amdgcn_global_load_lds((const unsigned*)((const char*)(gbase) + (voff)[_i]), (PG8_LAS unsigned*)(lds + (bufoff) + ldsw + _i * 8192), 16, 0, 0); } while (0)
#define PG8_LDA(dst, b, h) do { _Pragma("unroll") for (int m = 0; m < 4; ++m) _Pragma("unroll") for (int k = 0; k < 2; ++k) dst[m][k] = *(const PG8_LAS bf16x8*)(lds + PG8_SA(b, h) + aoff + m * 2048 + k * 1024); } while (0)
#define PG8_LDB(dst, b, h) do { _Pragma("unroll") for (int n = 0; n < 2; ++n) _Pragma("unroll") for (int k = 0; k < 2; ++k) dst[n][k] = *(const PG8_LAS bf16x8*)(lds + PG8_SB(b, h) + boff + n * 2048 + k * 1024); } while (0)
#define PG8_MMA(ai, bj, At, Bt) do { __builtin_amdgcn_s_setprio(1); _Pragma("unroll") for (int m = 0; m < 4; ++m) _Pragma("unroll") for (int n = 0; n < 2; ++n) _Pragma("unroll") for (int k = 0; k < 2; ++k) \
        acc[ai][bj][m][n] = __builtin_amdgcn_mfma_f32_16x16x32_bf16(Bt[n][k], At[m][k], acc[ai][bj][m][n], 0, 0, 0); __builtin_amdgcn_s_setprio(0); } while (0)
#define PG8_WAIT_V(n) asm volatile("s_waitcnt vmcnt(" #n ")" ::: "memory")
#define PG8_WAIT_L(n) asm volatile("s_waitcnt lgkmcnt(" #n ")" ::: "memory")
#define PG8_BAR __builtin_amdgcn_s_barrier()
#define PG8_SCHED __builtin_amdgcn_sched_barrier(0)
    Unit cur, nxt; int ui = 0;
    if (!S.next(0, cur)) return;
    f32x4 acc[2][2][4][2];
#pragma unroll
    for (int a = 0; a < 2; ++a)
#pragma unroll
        for (int b = 0; b < 2; ++b)
#pragma unroll
            for (int m = 0; m < 4; ++m)
#pragma unroll
                for (int n = 0; n < 2; ++n) acc[a][b][m][n] = (f32x4){0.f, 0.f, 0.f, 0.f};
    bf16x8 At[4][2], B0[2][2], B1[2][2];
    const char* cA = (const char*)g.A + (size_t)cur.pm * tstep; const char* cB = (const char*)g.Bt + (size_t)cur.pn * tstep;
    S.a_ready(cur);
    if constexpr (SP2) {
        PG8_STAGE(PG8_SB(0, 0), cB, voffB); PG8_STAGE(PG8_SB(0, 1), cB + hstep, voffB); PG8_STAGE(PG8_SA(0, 0), cA, voffA); PG8_STAGE(PG8_SA(0, 1), cA + hstep, voffA);
        if (wr == 1) PG8_BAR;
        PG8_WAIT_V(2); PG8_BAR;
        PG8_STAGE(PG8_SB(1, 0), cB + kstep, voffB); PG8_STAGE(PG8_SA(1, 0), cA + kstep, voffA); PG8_STAGE(PG8_SB(1, 1), cB + hstep + kstep, voffB);
        PG8_WAIT_V(6); PG8_BAR;
    } else {
        PG8_STAGE(PG8_SB(0, 0), cB, voffB); PG8_STAGE(PG8_SA(0, 0), cA, voffA); PG8_STAGE(PG8_SB(0, 1), cB + hstep, voffB); PG8_STAGE(PG8_SA(0, 1), cA + hstep, voffA);
        if (wr == 1) PG8_BAR;
        PG8_WAIT_V(4); PG8_BAR;
        PG8_STAGE(PG8_SB(1, 0), cB + kstep, voffB); PG8_STAGE(PG8_SA(1, 0), cA + kstep, voffA); PG8_STAGE(PG8_SB(1, 1), cB + hstep + kstep, voffB);
        PG8_WAIT_V(6); PG8_BAR;
    }
    for (;;) {
        const bool has_next = S.next(ui + 1, nxt);
        const char* nA = has_next ? (const char*)g.A + (size_t)nxt.pm * tstep : cA; const char* nB = has_next ? (const char*)g.Bt + (size_t)nxt.pn * tstep : cB;
        for (int t = 0; t < nt; t += 2) {
            const bool last = (t == nt - 2);
            const char* a1 = cA + (size_t)(t + 1) * kstep;
            const char* a2 = last ? nA : cA + (size_t)(t + 2) * kstep; const char* b2 = last ? nB : cB + (size_t)(t + 2) * kstep;
            const char* a3 = a2 + kstep; const char* b3 = b2 + kstep;
            if (last && has_next) S.a_ready(nxt);
            if constexpr (SP2) {
            PG8_LDB(B0, 0, 0); PG8_LDB(B1, 0, 1); PG8_SCHED; PG8_LDA(At, 0, 0); PG8_STAGE(PG8_SA(1, 1), a1 + hstep, voffA);
            PG8_WAIT_V(8); PG8_WAIT_L(0); PG8_BAR; PG8_MMA(0, 0, At, B0); PG8_MMA(0, 1, At, B1); PG8_BAR; PG8_SCHED;
            PG8_LDA(At, 0, 1); PG8_STAGE(PG8_SB(0, 0), b2, voffB); PG8_STAGE(PG8_SB(0, 1), b2 + hstep, voffB); PG8_STAGE(PG8_SA(0, 0), a2, voffA);
            PG8_WAIT_V(8); PG8_WAIT_L(0); PG8_BAR; PG8_MMA(1, 0, At, B0); PG8_MMA(1, 1, At, B1); PG8_BAR; PG8_SCHED;
            PG8_LDB(B0, 1, 0); PG8_LDB(B1, 1, 1); PG8_SCHED; PG8_LDA(At, 1, 0); PG8_STAGE(PG8_SA(0, 1), a2 + hstep, voffA);
            PG8_WAIT_V(8); PG8_WAIT_L(0); PG8_BAR; PG8_MMA(0, 0, At, B0); PG8_MMA(0, 1, At, B1); PG8_BAR; PG8_SCHED;
            PG8_LDA(At, 1, 1); PG8_STAGE(PG8_SB(1, 0), b3, voffB); PG8_STAGE(PG8_SB(1, 1), b3 + hstep, voffB); PG8_STAGE(PG8_SA(1, 0), a3, voffA);
            PG8_WAIT_V(8); PG8_WAIT_L(0); PG8_BAR; PG8_MMA(1, 0, At, B0); PG8_MMA(1, 1, At, B1); PG8_BAR; PG8_SCHED;
            } else {
            PG8_LDB(B0, 0, 0); PG8_SCHED; PG8_LDA(At, 0, 0); PG8_STAGE(PG8_SA(1, 1), a1 + hstep, voffA);
            PG8_WAIT_L(8); PG8_BAR; PG8_WAIT_L(0); PG8_MMA(0, 0, At, B0); PG8_BAR; PG8_SCHED;
            PG8_LDB(B1, 0, 1); PG8_STAGE(PG8_SB(0, 0), b2, voffB);
            PG8_BAR; PG8_WAIT_L(0); PG8_MMA(0, 1, At, B1); PG8_BAR;
            PG8_LDA(At, 0, 1); PG8_STAGE(PG8_SA(0, 0), a2, voffA);
            PG8_BAR; PG8_WAIT_L(0); PG8_MMA(1, 0, At, B0); PG8_BAR; PG8_SCHED;
            PG8_STAGE(PG8_SB(0, 1), b2 + hstep, voffB);
            PG8_WAIT_V(6); PG8_BAR; PG8_MMA(1, 1, At, B1); PG8_BAR;
            PG8_LDB(B0, 1, 0); PG8_SCHED; PG8_LDA(At, 1, 0); PG8_STAGE(PG8_SA(0, 1), a2 + hstep, voffA);
            PG8_WAIT_L(8); PG8_BAR; PG8_WAIT_L(0); PG8_MMA(0, 0, At, B0); PG8_BAR; PG8_SCHED;
            PG8_LDB(B1, 1, 1); PG8_STAGE(PG8_SB(1, 0), b3, voffB);
            PG8_BAR; PG8_WAIT_L(0); PG8_MMA(0, 1, At, B1); PG8_BAR;
            PG8_LDA(At, 1, 1); PG8_STAGE(PG8_SA(1, 0), a3, voffA);
            PG8_BAR; PG8_WAIT_L(0); PG8_MMA(1, 0, At, B0); PG8_BAR; PG8_SCHED;
            PG8_STAGE(PG8_SB(1, 1), b3 + hstep, voffB);
            PG8_WAIT_V(6); PG8_BAR; PG8_MMA(1, 1, At, B1); PG8_BAR;
            }
        }
        if constexpr (ALIGN_EPI) { if (wr == 0) PG8_BAR; }
        if constexpr (!Epi::AFTER_DRAIN) { E(acc, cur, wr, wc, fr, fq); S.done(cur); }
        if (!has_next) break;
#pragma unroll
        for (int a = 0; a < 2; ++a)
#pragma unroll
            for (int b = 0; b < 2; ++b)
#pragma unroll
                for (int m = 0; m < 4; ++m)
#pragma unroll
                    for (int n = 0; n < 2; ++n) acc[a][b][m][n] = (f32x4){0.f, 0.f, 0.f, 0.f};
        cur = nxt; cA = nA; cB = nB; ++ui;
        if constexpr (ALIGN_EPI) { if (wr == 1) PG8_BAR; }
    }
    PG8_WAIT_V(0);
    if constexpr (!ALIGN_EPI) { if (wr == 0) PG8_BAR; }
    PG8_BAR;
    if constexpr (Epi::AFTER_DRAIN) { E.fused(acc, cur, wr, wc, fr, fq, lds, wid, lane); S.done(cur); }
#undef PG8_SA
#undef PG8_SB
#undef PG8_STAGE
#undef PG8_LDA
#undef PG8_LDB
#undef PG8_MMA
#undef PG8_WAIT_V
#undef PG8_WAIT_L
#undef PG8_BAR
#undef PG8_SCHED
}
}

#define LAS __attribute__((address_space(3)))
typedef unsigned short bf16;
typedef unsigned v4u __attribute__((ext_vector_type(4)));
typedef unsigned v2u __attribute__((ext_vector_type(2)));
typedef float f32x4 __attribute__((ext_vector_type(4)));
typedef float f32x16 __attribute__((ext_vector_type(16)));
typedef short bf16x8 __attribute__((ext_vector_type(8)));
typedef short s16x4 __attribute__((ext_vector_type(4)));
typedef float f32x2_t __attribute__((ext_vector_type(2)));
typedef __bf16 bf16x2_t __attribute__((ext_vector_type(2)));

constexpr int NWAVES = 8;
constexpr int DM = 1024, TP = 16384, NPB = 2, TS = 64, NSB = 16, PAST = 2048, TKS = PAST + TS;
constexpr int MP = NPB * TP, MS = NSB * TS, MTOK = MP + MS, MKV = MTOK + NSB * PAST;
constexpr int QLORA = 384, KVLORA = 256, ROPE = 32, CONVCH = 512, CONVK = 31, DFF = 2816, NH = 8, HD = 96, VD = 64;
constexpr int NIN_PAD = 1792;
constexpr float EPS = 1e-6f;
constexpr size_t O_YP = 0, O_YS = 33554432, O_CKVP = 34603008, O_KPEP = 42991616, O_CONVP = 44040192, O_FFNP = 44070912,
                 O_CKVS = 44082176, O_KPES = 44344320, O_CONVS = 44377088, O_FFNS = 44622848, O_TOTAL = 44712960;
constexpr size_t MiB = 1u << 20;
constexpr size_t WS_CTL = 0, CTL_ZERO_BYTES = 65536; constexpr int CW_BAR = 4096;
constexpr size_t WS_WIN = 1 * MiB, WS_WUQ = 5 * MiB, WS_WUKV = 6 * MiB, WS_WOUT = 7 * MiB, WS_WUP = 9 * MiB, WS_WDOWN = 20 * MiB, WS_ROPEC = 26 * MiB, WS_ROPES = 27 * MiB;
constexpr size_t WS_XN = 32 * MiB;
constexpr size_t WS_V = 32 * MiB;
constexpr size_t WS_MIX = 98 * MiB;
constexpr size_t WS_PROJ = 164 * MiB;
constexpr size_t WS_A3 = 331 * MiB;
constexpr size_t WS_CQN = 364 * MiB;
constexpr size_t WS_Q = 164 * MiB;
constexpr size_t WS_U = 164 * MiB + 100 * MiB;
constexpr size_t WS_K = 404 * MiB;
constexpr size_t WS_AUXA = 98 * MiB;
constexpr size_t WS_AUXG = 122 * MiB;
constexpr size_t WS_UPG = 280 * MiB;
constexpr size_t WS_END = 512 * MiB;
static_assert(WS_K + (size_t)(NPB * NH * TP + NSB * NH * TKS) * HD * 2 <= WS_END, "ws map");
static_assert(WS_UPG + (size_t)MTOK * DFF * 2 <= WS_END && WS_AUXA + (size_t)(MTOK / 64) * 4 * DFF * 4 <= WS_AUXG && WS_AUXG + (size_t)(MTOK / 64) * 2 * DFF * 4 <= WS_UPG, "ws map");
static_assert(WS_PROJ + (size_t)MTOK * 768 * 4 <= WS_U && WS_Q + (size_t)MTOK * 768 * 2 <= WS_U && WS_U + (size_t)MTOK * 512 * 4 <= WS_A3 && WS_A3 + (size_t)MKV * 256 * 2 <= WS_CQN && WS_CQN + (size_t)MTOK * 384 * 2 <= WS_K, "ws map");
static_assert(WS_V + (size_t)(NPB * NH * TP + NSB * NH * TKS) * VD * 2 <= WS_MIX && WS_MIX + (size_t)MTOK * 1024 * 2 <= WS_PROJ, "ws map");

constexpr int RING_BYTES = 131072;
constexpr int LDS_BYTES = 147456;

#define LDS_WAIT() asm volatile("s_waitcnt lgkmcnt(0)" ::: "memory")
__device__ __forceinline__ unsigned f2bf(float f) { unsigned u = __builtin_bit_cast(unsigned, f); return (u + 0x7fffu + ((u >> 16) & 1u)) >> 16; }
__device__ __forceinline__ unsigned pk2(float lo, float hi) { f32x2_t v = {lo, hi}; bf16x2_t b = __builtin_convertvector(v, bf16x2_t); return __builtin_bit_cast(unsigned, b); }
__device__ __forceinline__ float bflo(unsigned w) { return __uint_as_float(w << 16); }
__device__ __forceinline__ float bfhi(unsigned w) { return __uint_as_float(w & 0xffff0000u); }
__device__ __forceinline__ float wave_sum(float v) {
#pragma unroll
    for (int o = 1; o < 64; o <<= 1) v += __shfl_xor(v, o);
    return v;
}
__device__ __forceinline__ float sigmoidf_(float x) { return __builtin_amdgcn_rcpf(1.f + __expf(-x)); }

__device__ __forceinline__ int win_row(int n) {
    if (n < 672) return n;
    if (n < 1184) { const int ch = n - 672; return 768 + (ch >> 2) * 8 + (ch & 3); }
    const int ch = n - 1184; return 768 + (ch >> 2) * 8 + 4 + (ch & 3);
}
__device__ __forceinline__ int wup_row(int n) {
    if (n < 2816) return 256 * (n >> 7) + 8 * ((n & 127) >> 2) + (n & 3);
    const int ch = n - 2816; return 256 * (ch >> 7) + 8 * ((ch & 127) >> 2) + 4 + (ch & 3);
}
__device__ __forceinline__ int wukv_row(int n) {
    const int h = n >> 7, isv = (n >> 6) & 1, d = n & 63;
    return 256 * (h >> 1) + 128 * (d >> 5) + 32 * (2 * (h & 1) + isv) + (d & 31);
}
template <int RMAP>
__device__ __forceinline__ void p0_transpose_item(const float* W, int K, int N, bf16* WT, LAS float* scr, int item, int lane) {
    const int nblk = N / 32, kb = item / nblk, nb = item % nblk, k0 = 64 * kb, n0 = 32 * nb;
#pragma unroll 8
    for (int i = 0; i < 32; ++i) { const int kk = 2 * i + (lane >> 5); scr[kk * 33 + (lane & 31)] = W[(size_t)(k0 + kk) * N + n0 + (lane & 31)]; }
    LDS_WAIT(); asm volatile("" ::: "memory");
    const int c = lane & 7;
#pragma unroll
    for (int j = 0; j < 4; ++j) { const int n = (lane >> 3) + 8 * j; const LAS float* s = scr + (8 * c) * 33 + n;
        v4u o; o.x = pk2(s[0 * 33], s[1 * 33]); o.y = pk2(s[2 * 33], s[3 * 33]); o.z = pk2(s[4 * 33], s[5 * 33]); o.w = pk2(s[6 * 33], s[7 * 33]);
        const int drow = (RMAP == 1) ? win_row(n0 + n) : (RMAP == 2) ? wup_row(n0 + n) : (RMAP == 3) ? wukv_row(n0 + n) : (n0 + n);
        *(v4u*)(WT + (size_t)drow * K + k0 + 8 * c) = o; }
    LDS_WAIT(); asm volatile("" ::: "memory");
}
__device__ __forceinline__ void rms_row_to_bf16(const float* xrow, const float* g, bf16* orow, int lane) {
    const f32x4* xr = (const f32x4*)xrow + lane; const f32x4* gr = (const f32x4*)g + lane;
    f32x4 v[4]; float s = 0.f;
#pragma unroll
    for (int j = 0; j < 4; ++j) { v[j] = xr[64 * j]; s += (v[j].x * v[j].x + v[j].y * v[j].y) + (v[j].z * v[j].z + v[j].w * v[j].w); }
    const float rstd = 1.f / sqrtf(wave_sum(s) * (1.f / 1024.f) + EPS);
    v2u* o8 = (v2u*)orow + lane;
#pragma unroll
    for (int j = 0; j < 4; ++j) { const f32x4 gg = gr[64 * j]; v2u o; o.x = pk2(v[j].x * rstd * gg.x, v[j].y * rstd * gg.y); o.y = pk2(v[j].z * rstd * gg.z, v[j].w * rstd * gg.w); o8[64 * j] = o; }
}
template <int NR, class RowPtr>
__device__ __forceinline__ void rms_rows_to_bf16(const RowPtr& rowptr, int m0, int stride, int mlim, const float* g, bf16* O, int lane) {
    f32x4 v[NR][4]; float ss[NR];
#pragma unroll
    for (int r = 0; r < NR; ++r) { const int m = m0 + r * stride; const float* x = rowptr(m < mlim ? m : m0);
#pragma unroll
        for (int j = 0; j < 2; ++j) { v[r][2 * j] = *(const f32x4*)(x + 512 * j + 8 * lane); v[r][2 * j + 1] = *(const f32x4*)(x + 512 * j + 8 * lane + 4); } }
#pragma unroll
    for (int r = 0; r < NR; ++r) { float s = 0.f;
#pragma unroll
        for (int j = 0; j < 4; ++j) s += (v[r][j].x * v[r][j].x + v[r][j].y * v[r][j].y) + (v[r][j].z * v[r][j].z + v[r][j].w * v[r][j].w);
        ss[r] = s; }
#pragma unroll
    for (int o = 1; o < 64; o <<= 1) {
#pragma unroll
        for (int r = 0; r < NR; ++r) ss[r] += __shfl_xor(ss[r], o); }
#pragma unroll
    for (int r = 0; r < NR; ++r) { const int m = m0 + r * stride; if (m < mlim) { const float rstd = 1.f / sqrtf(ss[r] * (1.f / 1024.f) + EPS);
#pragma unroll
        for (int j = 0; j < 2; ++j) { const f32x4 g0 = *(const f32x4*)(g + 512 * j + 8 * lane), g1 = *(const f32x4*)(g + 512 * j + 8 * lane + 4);
            const f32x4 a0 = v[r][2 * j] * rstd * g0, a1 = v[r][2 * j + 1] * rstd * g1; v4u a;
            a.x = pk2(a0.x, a0.y); a.y = pk2(a0.z, a0.w); a.z = pk2(a1.x, a1.y); a.w = pk2(a1.z, a1.w); *(v4u*)(O + (size_t)m * 1024 + 512 * j + 8 * lane) = a; } } }
}
__device__ __forceinline__ void sincos_acc(float ang, float& sn, float& cs) {
    const double x = (double)ang;
    const double n = __builtin_rint(x * 0.63661977236758134308);
    double r = x - n * 1.57079632679489655800e+00; r -= n * 6.12323399573676603587e-17;
    const double r2 = r * r;
    double sp = -7.6471637318198164759e-13; sp = sp * r2 + 1.6059043836821614599e-10; sp = sp * r2 - 2.5052108385441718775e-08; sp = sp * r2 + 2.7557319223985890653e-06;
    sp = sp * r2 - 1.9841269841269841270e-04; sp = sp * r2 + 8.3333333333333333333e-03; sp = sp * r2 - 1.6666666666666666667e-01; const double s = r + r * r2 * sp;
    double cp = 4.7794773323873852974e-14; cp = cp * r2 - 1.1470745597729724714e-11; cp = cp * r2 + 2.0876756987868098979e-09; cp = cp * r2 - 2.7557319223985890653e-07;
    cp = cp * r2 + 2.4801587301587301587e-05; cp = cp * r2 - 1.3888888888888888889e-03; cp = cp * r2 + 4.1666666666666666667e-02; cp = cp * r2 - 0.5; const double c = 1.0 + r2 * cp;
    const int q = ((int)n) & 3;
    const double ss = (q == 0) ? s : (q == 1) ? c : (q == 2) ? -s : -c;
    const double cc = (q == 0) ? c : (q == 1) ? -s : (q == 2) ? -c : s;
    sn = (float)ss; cs = (float)cc;
}

namespace att {
constexpr int KSLOT = 12288, VSLOT = 8192;
constexpr int LDS_K = 0, LDS_V = 2 * KSLOT, LDS_WS = LDS_V + 2 * VSLOT, LDS_END = LDS_WS + NWAVES * 32 * 4;
__device__ __forceinline__ int crow(int r, int hi) { return (r & 3) + 8 * (r >> 2) + 4 * hi; }
__device__ __forceinline__ void glds16(const void* gsrc, unsigned lds_dst) { unsigned keep;
    asm volatile("s_mov_b32 %0, m0\n\ts_mov_b32 m0, %2\n\ts_nop 0\n\tglobal_load_lds_dwordx4 %1, off\n\ts_mov_b32 m0, %0" : "=&s"(keep) : "v"(gsrc), "s"(lds_dst) : "memory"); }
typedef short v4i16_t __attribute__((ext_vector_type(4)));
__device__ __forceinline__ s16x4 vtr(const LAS char* p) { return __builtin_bit_cast(s16x4, __builtin_amdgcn_ds_read_tr16_b64_v4i16((LAS v4i16_t*)p)); }
#define MFMA32(a, b, c) __builtin_amdgcn_mfma_f32_32x32x16_bf16((a), (b), (c), 0, 0, 0)

__device__ __forceinline__ void attn_unit(LAS unsigned char* lds, const bf16* Qrows, const bf16* Kb, const bf16* Vb, bf16* Orows, int pos0, int nrows,
                                          const float* gq, const float* gk, const float* ropec, const float* ropes) {
    int tid = threadIdx.x; asm volatile("" : "+v"(tid)); const int lane = tid & 63, r32 = lane & 31, hi = lane >> 5; const int wid = __builtin_amdgcn_readfirstlane(tid >> 6);
    const unsigned lds0 = (unsigned)(uintptr_t)lds;
    const bool active = (wid * 32 < nrows);
    const int NT = (pos0 + nrows - 1) / 64 + 1;
    const int ntw = active ? (pos0 + wid * 32) / 64 + 1 : 0;
    LAS float* wsf = (LAS float*)(lds + LDS_WS) + wid * 32;
    const bf16* ksrc = Kb + (size_t)lane * HD + wid * 8;
    const bf16* vsrc = Vb + (size_t)(16 * (wid & 3) + (lane >> 2)) * VD + (wid >> 2) * 32 + (lane & 3) * 8;
#define ATT_DMA_K(t, slot) do { glds16(ksrc + (size_t)(t) * 64 * HD, (unsigned)__builtin_amdgcn_readfirstlane(lds0 + LDS_K + (slot) * KSLOT + wid * 1024)); \
        if (wid < 4) glds16(ksrc + (size_t)(t) * 64 * HD + 64, (unsigned)__builtin_amdgcn_readfirstlane(lds0 + LDS_K + (slot) * KSLOT + (8 + wid) * 1024)); } while (0)
#define ATT_DMA_V(t, slot) glds16(vsrc + (size_t)(t) * 64 * VD, (unsigned)__builtin_amdgcn_readfirstlane(lds0 + LDS_V + (slot) * VSLOT + wid * 1024))
    ATT_DMA_K(0, 0); if (NT > 1) ATT_DMA_K(1, 1); ATT_DMA_V(0, 0);
    bf16x8 qr[6];
#pragma unroll
    for (int d0 = 0; d0 < 6; ++d0) qr[d0] = (bf16x8){0, 0, 0, 0, 0, 0, 0, 0};
    if (active) {
        const bf16* qp = Qrows + (size_t)(32 * wid + r32) * 768 + 8 * hi;
        float qv[6][8]; float ss = 0.f;
#pragma unroll
        for (int d0 = 0; d0 < 6; ++d0) { const v4u raw = *(const v4u*)(qp + 16 * d0);
#pragma unroll
            for (int j = 0; j < 4; ++j) { qv[d0][2 * j] = bflo(raw[j]); qv[d0][2 * j + 1] = bfhi(raw[j]); }
#pragma unroll
            for (int j = 0; j < 8; ++j) ss += qv[d0][j] * qv[d0][j]; }
        ss += __shfl_xor(ss, 32);
        const float rstd = 1.f / sqrtf(ss * (1.f / 96.f) + EPS);
#pragma unroll
        for (int d0 = 0; d0 < 6; ++d0)
#pragma unroll
            for (int j = 0; j < 8; ++j) qv[d0][j] *= rstd * gq[16 * d0 + 8 * hi + j];
        const int pos = pos0 + 32 * wid + r32;
        const float* cs = ropec + (size_t)pos * 16 + 8 * hi; const float* sn = ropes + (size_t)pos * 16 + 8 * hi;
#pragma unroll
        for (int j = 0; j < 8; ++j) { const float c = cs[j], s = sn[j], p1 = qv[4][j], p2 = qv[5][j]; qv[4][j] = p1 * c - p2 * s; qv[5][j] = p2 * c + p1 * s; }
        const float qs = 0.10206207261596575f * 1.4426950408889634f;
#pragma unroll
        for (int d0 = 0; d0 < 6; ++d0) { v4u w;
#pragma unroll
            for (int j = 0; j < 4; ++j) w[j] = pk2(qv[d0][2 * j] * qs, qv[d0][2 * j + 1] * qs);
            qr[d0] = __builtin_bit_cast(bf16x8, w); }
    }
    constexpr float THR = 24.f;
    bool safe;
    { float mq = fmaxf(fabsf(gq[lane]), (lane < 32) ? fabsf(gq[64 + lane]) : 0.f), mk = fmaxf(fabsf(gk[lane]), (lane < 32) ? fabsf(gk[64 + lane]) : 0.f);
#pragma unroll
      for (int o_ = 1; o_ < 64; o_ <<= 1) { mq = fmaxf(mq, __shfl_xor(mq, o_)); mk = fmaxf(mk, __shfl_xor(mk, o_)); }
      safe = __all(14.2f * mq * mk < THR) != 0; }
    float m_run = 0.f, l_run = 0.f;
    f32x16 o[2], negm;
#pragma unroll
    for (int r = 0; r < 16; ++r) { o[0][r] = 0.f; o[1][r] = 0.f; negm[r] = 0.f; }
    const LAS char* kp0 = (const LAS char*)lds + LDS_K + hi * 1024 + r32 * 16;
    const LAS char* vp0 = (const LAS char*)lds + LDS_V + ((lane >> 4) & 1) * 32 + (lane & 3) * 8 + (4 * hi + ((lane & 15) >> 2)) * 64;
#define SBAR() __builtin_amdgcn_sched_barrier(0)
#define MX3(a, b, c) __builtin_fmaxf(__builtin_fmaxf((a), (b)), (c))
#define QK_STEP(N0, N1, KP, d0, CIN0, CIN1) do { const bf16x8 k0_ = *(const LAS bf16x8*)((KP) + (d0) * 2048), k1_ = *(const LAS bf16x8*)((KP) + (d0) * 2048 + 512); \
        N0 = MFMA32(k0_, qr[d0], CIN0); N1 = MFMA32(k1_, qr[d0], CIN1); } while (0)
#define TILE_MAX(M, C0, C1) do { float a_ = MX3(C0[0], C0[1], C1[0]), b_ = MX3(C0[2], C0[3], C1[1]); a_ = MX3(a_, C1[2], C1[3]); \
        _Pragma("unroll") for (int r = 4; r < 16; r += 4) { a_ = MX3(a_, C0[r], C0[r + 1]); b_ = MX3(b_, C0[r + 2], C0[r + 3]); a_ = MX3(a_, C1[r], C1[r + 1]); b_ = MX3(b_, C1[r + 2], C1[r + 3]); } \
        M = __builtin_fmaxf(a_, b_); } while (0)
#define SM_EXP8(C, B) do { _Pragma("unroll") for (int r = (B); r < (B) + 8; ++r) { C[r] = __builtin_amdgcn_exp2f(C[r]); rs += C[r]; } } while (0)
#define SM_PACK() do { v4u w_; \
        w_.x = pk2(c0[0], c0[1]); w_.y = pk2(c0[2], c0[3]); w_.z = pk2(c0[4], c0[5]); w_.w = pk2(c0[6], c0[7]); pa[0] = __builtin_bit_cast(bf16x8, w_); \
        w_.x = pk2(c0[8], c0[9]); w_.y = pk2(c0[10], c0[11]); w_.z = pk2(c0[12], c0[13]); w_.w = pk2(c0[14], c0[15]); pa[1] = __builtin_bit_cast(bf16x8, w_); \
        w_.x = pk2(c1[0], c1[1]); w_.y = pk2(c1[2], c1[3]); w_.z = pk2(c1[4], c1[5]); w_.w = pk2(c1[6], c1[7]); pa[2] = __builtin_bit_cast(bf16x8, w_); \
        w_.x = pk2(c1[8], c1[9]); w_.y = pk2(c1[10], c1[11]); w_.z = pk2(c1[12], c1[13]); w_.w = pk2(c1[14], c1[15]); pa[3] = __builtin_bit_cast(bf16x8, w_); \
        l_run += rs; } while (0)
#define FIX_REF() do { if (__any(mxc > THR)) { const float mx_ = __builtin_fmaxf(mxc, __shfl_xor(mxc, 32)); const float dl_ = __builtin_fmaxf(mx_, 0.f); \
        m_run += dl_; _Pragma("unroll") for (int r = 0; r < 16; ++r) { c0[r] -= dl_; c1[r] -= dl_; negm[r] = -m_run; } \
        const float f_ = __builtin_amdgcn_exp2f(-dl_); l_run *= f_; if (hi == 0) wsf[r32] = f_; LDS_WAIT(); \
        _Pragma("unroll") for (int r = 0; r < 16; ++r) { const float a_ = wsf[crow(r, hi)]; o[0][r] *= a_; o[1][r] *= a_; } LDS_WAIT(); } } while (0)
#define PV_TILE(VP) do { _Pragma("unroll") for (int s_ = 0; s_ < 4; ++s_) _Pragma("unroll") for (int dh = 0; dh < 2; ++dh) { \
        const s16x4 lo_ = vtr((VP) + dh * 4096 + s_ * 1024), h4_ = vtr((VP) + dh * 4096 + s_ * 1024 + 512); \
        const bf16x8 vf_ = (bf16x8){lo_[0], lo_[1], lo_[2], lo_[3], h4_[0], h4_[1], h4_[2], h4_[3]}; \
        o[dh] = MFMA32(pa[s_], vf_, o[dh]); } } while (0)
    asm volatile("s_waitcnt vmcnt(0)" ::: "memory");
    __builtin_amdgcn_s_barrier();
    f32x16 c0 = negm, c1 = negm; float mxc = 0.f;
    if (ntw > 0) {
#pragma unroll
        for (int d0 = 0; d0 < 6; ++d0) QK_STEP(c0, c1, kp0, d0, c0, c1);
        if (!safe) TILE_MAX(mxc, c0, c1);
    }
    for (int t = 0; t < NT; ++t) {
        asm volatile("s_waitcnt vmcnt(0)" ::: "memory");
        __builtin_amdgcn_s_barrier();
        if (t + 2 < NT) ATT_DMA_K(t + 2, t & 1);
        if (t + 1 < NT) ATT_DMA_V(t + 1, (t + 1) & 1);
        if (t + 1 < ntw) {
            FIX_REF();
            const LAS char* kp = kp0 + ((t + 1) & 1) * KSLOT; const LAS char* vp = vp0 + (t & 1) * VSLOT;
            f32x16 n0, n1; bf16x8 pa[4]; float rs = 0.f;
#define KLD(A0, A1, d0) do { A0 = *(const LAS bf16x8*)(kp + (d0) * 2048); A1 = *(const LAS bf16x8*)(kp + (d0) * 2048 + 512); } while (0)
#define VLD(F, s_, dh) do { const s16x4 lo_ = vtr(vp + (dh) * 4096 + (s_) * 1024), h4_ = vtr(vp + (dh) * 4096 + (s_) * 1024 + 512); \
        F = (bf16x8){lo_[0], lo_[1], lo_[2], lo_[3], h4_[0], h4_[1], h4_[2], h4_[3]}; } while (0)
            bf16x8 ka0, ka1, kb0, kb1, va0, va1, vb0, vb1;
            SBAR();
            KLD(ka0, ka1, 0); KLD(kb0, kb1, 1); SM_EXP8(c0, 0); SBAR();
            n0 = MFMA32(ka0, qr[0], negm); n1 = MFMA32(ka1, qr[0], negm); KLD(ka0, ka1, 2); SM_EXP8(c0, 8); SBAR();
            n0 = MFMA32(kb0, qr[1], n0); n1 = MFMA32(kb1, qr[1], n1); KLD(kb0, kb1, 3); SM_EXP8(c1, 0); SBAR();
            n0 = MFMA32(ka0, qr[2], n0); n1 = MFMA32(ka1, qr[2], n1); KLD(ka0, ka1, 4); SM_EXP8(c1, 8); SBAR();
            n0 = MFMA32(kb0, qr[3], n0); n1 = MFMA32(kb1, qr[3], n1); KLD(kb0, kb1, 5); SM_PACK(); SBAR();
            n0 = MFMA32(ka0, qr[4], n0); n1 = MFMA32(ka1, qr[4], n1); VLD(va0, 0, 0); VLD(va1, 0, 1); SBAR();
            n0 = MFMA32(kb0, qr[5], n0); n1 = MFMA32(kb1, qr[5], n1); VLD(vb0, 1, 0); VLD(vb1, 1, 1); SBAR();
            o[0] = MFMA32(pa[0], va0, o[0]); o[1] = MFMA32(pa[0], va1, o[1]); VLD(va0, 2, 0); VLD(va1, 2, 1); SBAR();
            o[0] = MFMA32(pa[1], vb0, o[0]); o[1] = MFMA32(pa[1], vb1, o[1]); VLD(vb0, 3, 0); VLD(vb1, 3, 1); SBAR();
            o[0] = MFMA32(pa[2], va0, o[0]); o[1] = MFMA32(pa[2], va1, o[1]); SBAR();
            o[0] = MFMA32(pa[3], vb0, o[0]); o[1] = MFMA32(pa[3], vb1, o[1]);
#undef KLD
#undef VLD
            c0 = n0; c1 = n1;
            if (!safe) TILE_MAX(mxc, c0, c1);
        } else if (t < ntw) {
            FIX_REF();
            const LAS char* vp = vp0 + (t & 1) * VSLOT;
            bf16x8 pa[4]; float rs = 0.f;
            SM_EXP8(c0, 0); SM_EXP8(c0, 8); SM_EXP8(c1, 0); SM_EXP8(c1, 8); SM_PACK();
            PV_TILE(vp);
        }
    }
#undef SBAR
#undef MX3
#undef QK_STEP
#undef TILE_MAX
#undef SM_EXP8
#undef SM_PACK
#undef FIX_REF
#undef PV_TILE
    if (active) {
        l_run += __shfl_xor(l_run, 32);
        if (hi == 0) wsf[r32] = l_run;
        LDS_WAIT();
        int r32b = r32, hib = hi; asm volatile("" : "+v"(r32b), "+v"(hib));
        bf16* op = Orows + (size_t)(32 * wid + 4 * hib) * 1024 + r32b;
        const LAS float* lw = wsf + 4 * hib;
#pragma unroll
        for (int r = 0; r < 16; ++r) { const int q = (r & 3) + 8 * (r >> 2); const float inv = __builtin_amdgcn_rcpf(lw[q]);
            op[(size_t)q * 1024] = (bf16)f2bf(o[0][r] * inv); op[(size_t)q * 1024 + 32] = (bf16)f2bf(o[1][r] * inv); }
    }
    asm volatile("s_waitcnt lgkmcnt(0)" ::: "memory");
    __builtin_amdgcn_s_barrier();
#undef ATT_DMA_K
#undef ATT_DMA_V
}
}

#define XB_TMO      128
#define XB_XCNT(j)  (256  + 64 * (j))
#define XB_XSUB(j)  (1280 + 64 * (j))
#define XB_XGEN(j)  (2304 + 64 * (j))
#define XB_TOP      3328
#define XB_TOPGEN   3392
#define XCD_BAR_WORDS 3456
#define XB_SPIN_CAP (1u << 18)

__device__ __forceinline__ unsigned xb_ld(unsigned* p)              { return __hip_atomic_load(p, __ATOMIC_RELAXED, __HIP_MEMORY_SCOPE_AGENT); }
__device__ __forceinline__ unsigned xb_add(unsigned* p, unsigned v) { return __hip_atomic_fetch_add(p, v, __ATOMIC_RELAXED, __HIP_MEMORY_SCOPE_AGENT); }
__device__ __forceinline__ unsigned xb_xcc_id() { return (unsigned)__builtin_amdgcn_s_getreg((3 << 11) | 20) & 0xFu; }
#define XB_SPIN(cond, bar) do { unsigned _sp = 0; while (cond) { __builtin_amdgcn_s_sleep(1); \
    if ((++_sp & 255u) == 0u) { if (xb_ld(&(bar)[XB_TMO])) break; if (_sp > XB_SPIN_CAP) { atomicAdd(&(bar)[XB_TMO], 1u); break; } } } } while (0)

struct XcdBarrier {
    unsigned* bar; unsigned x;
    volatile LAS unsigned* st;
};

__device__ __forceinline__ XcdBarrier xcd_barrier_post(unsigned* bar, volatile LAS unsigned* st) {
    XcdBarrier b; b.bar = bar; b.x = xb_xcc_id(); b.st = st;
    if (threadIdx.x == 0) (void)xb_add(&bar[XB_XCNT(b.x)], 1u);
    return b;
}
__device__ __forceinline__ void xcd_barrier_complete(unsigned* bar, unsigned x, unsigned& nloc, unsigned& nx) {
    const unsigned G = gridDim.x * gridDim.y * gridDim.z;
    unsigned sum, cnt, mine, sp = 0u;
    for (;;) {
        sum = 0u; cnt = 0u; mine = 0u;
#pragma unroll
        for (unsigned j = 0; j < 16; ++j) { const unsigned c = xb_ld(&bar[XB_XCNT(j)]); sum += c; cnt += (c > 0u) ? 1u : 0u; mine = (j == x) ? c : mine; }
        if (sum == G) break;
        __builtin_amdgcn_s_sleep(1);
        if ((++sp & 255u) == 0u) { if (xb_ld(&bar[XB_TMO])) break; if (sp > XB_SPIN_CAP) { atomicAdd(&bar[XB_TMO], 1u); break; } }
    }
    nloc = mine > 0u ? mine : 1u; nx = cnt > 0u ? cnt : 1u;
}

__device__ __forceinline__ void xcd_barrier(const XcdBarrier& b) {
    asm volatile("s_waitcnt vmcnt(0)" ::: "memory");
    __syncthreads();
    if (threadIdx.x == 0) {
        unsigned* bar = b.bar;
        __builtin_amdgcn_s_waitcnt(0);
        unsigned nloc = b.st[0], nx = b.st[1];
        if (nloc == 0u) { xcd_barrier_complete(bar, b.x, nloc, nx); b.st[0] = nloc; b.st[1] = nx; }
        const unsigned old = xb_add(&bar[XB_XSUB(b.x)], 1u);
        const unsigned gen = old / nloc;
        if (old + 1u == (gen + 1u) * nloc) {
            __builtin_amdgcn_fence(__ATOMIC_RELEASE, "agent");
            asm volatile("s_waitcnt vmcnt(0)" ::: "memory");
            const unsigned og = xb_add(&bar[XB_TOP], 1u);
            const unsigned tg = og / nx;
            if (og + 1u == (tg + 1u) * nx) xb_add(&bar[XB_TOPGEN], 1u);
            else XB_SPIN(xb_ld(&bar[XB_TOPGEN]) == tg, bar);
            __builtin_amdgcn_fence(__ATOMIC_ACQUIRE, "agent");
            xb_add(&bar[XB_XGEN(b.x)], 1u);
            asm volatile("s_waitcnt vmcnt(0)" ::: "memory");
        } else {
            XB_SPIN(xb_ld(&bar[XB_XGEN(b.x)]) == gen, bar);
            __builtin_amdgcn_fence(__ATOMIC_ACQUIRE, "agent");
            asm volatile("s_waitcnt vmcnt(0)" ::: "memory");
        }
    }
    __syncthreads();
}

struct Args { const float* in[23]; float* out; unsigned char* ws; };
enum { I_XP = 0, I_XS, I_CKV, I_KPE, I_SCONV, I_SFFN, I_ATTN_NORM, I_WIN, I_QNORM, I_WUQ, I_KVNORM, I_WUKV, I_QKNQ, I_QKNK, I_CONVW, I_CONVB, I_CONVN, I_WOUT, I_FFNN, I_WUP, I_FCW, I_FCB, I_WDOWN };

__global__ void __launch_bounds__(NWAVES * 64, 2) mk_fwd(Args args) {
    extern __shared__ __attribute__((aligned(16))) unsigned char lds_raw[];
    LAS unsigned char* lds = (LAS unsigned char*)lds_raw;
    const int G = gridDim.x, bx = blockIdx.x;
    const int vcu = (G % 8 == 0) ? (bx % 8) * (G / 8) + bx / 8 : bx;
    const int NGW = G * NWAVES; const size_t NGT = (size_t)G * NWAVES * 64;
#define PHASE_IDS() int tid = threadIdx.x; asm volatile("" : "+v"(tid)); const int lane = tid & 63, wave = __builtin_amdgcn_readfirstlane(tid >> 6); \
    const int gw = vcu * NWAVES + wave; const size_t gtid = (size_t)bx * (NWAVES * 64) + tid; (void)lane; (void)gw; (void)gtid
    unsigned char* ws = args.ws; float* out = args.out;
    volatile LAS unsigned* bar_st = (volatile LAS unsigned*)(lds + RING_BYTES + 512);
    if (threadIdx.x < 4) bar_st[threadIdx.x] = 0u;
    __syncthreads();
    const XcdBarrier xbar = xcd_barrier_post((unsigned*)(ws + WS_CTL) + CW_BAR, bar_st);
#define GRID_BAR() xcd_barrier(xbar)
    const float* xp = args.in[I_XP]; const float* xs = args.in[I_XS];
    bf16* Win_t = (bf16*)(ws + WS_WIN); bf16* Wuq_t = (bf16*)(ws + WS_WUQ); bf16* Wukv_t = (bf16*)(ws + WS_WUKV); bf16* Wout_t = (bf16*)(ws + WS_WOUT);
    bf16* Wup_t = (bf16*)(ws + WS_WUP); bf16* Wdown_t = (bf16*)(ws + WS_WDOWN);
    float* ropec = (float*)(ws + WS_ROPEC); float* ropes = (float*)(ws + WS_ROPES);
    bf16* XN = (bf16*)(ws + WS_XN); bf16* Vbuf = (bf16*)(ws + WS_V); bf16* MIX = (bf16*)(ws + WS_MIX); float* PROJ = (float*)(ws + WS_PROJ);
    bf16* A3 = (bf16*)(ws + WS_A3); bf16* CQN = (bf16*)(ws + WS_CQN); bf16* Qb = (bf16*)(ws + WS_Q);
    float* U = (float*)(ws + WS_U); bf16* Kbuf = (bf16*)(ws + WS_K); float* AUXA = (float*)(ws + WS_AUXA); float* AUXG = (float*)(ws + WS_AUXG); bf16* UPG = (bf16*)(ws + WS_UPG);

    {
        PHASE_IDS();
        LAS float* scr = (LAS float*)(lds + wave * 16384);
        constexpr int I_IN = (1024 / 64) * (1696 / 32), I_UQ = (384 / 64) * (768 / 32), I_UKV = (256 / 64) * (1024 / 32), I_OUT = (1024 / 64) * (1024 / 32),
                      I_UP = (1024 / 64) * (5632 / 32), I_DOWN = (2816 / 64) * (1024 / 32);
        constexpr int NITEMS = I_IN + I_UQ + I_UKV + I_OUT + I_UP + I_DOWN;
        for (int it = gw; it < NITEMS; it += NGW) {
            int r = it;
            if (r < I_IN) { p0_transpose_item<1>(args.in[I_WIN], 1024, 1696, Win_t, scr, r, lane); continue; } r -= I_IN;
            if (r < I_UQ) { p0_transpose_item<0>(args.in[I_WUQ], 384, 768, Wuq_t, scr, r, lane); continue; } r -= I_UQ;
            if (r < I_UKV) { p0_transpose_item<3>(args.in[I_WUKV], 256, 1024, Wukv_t, scr, r, lane); continue; } r -= I_UKV;
            if (r < I_OUT) { p0_transpose_item<0>(args.in[I_WOUT], 1024, 1024, Wout_t, scr, r, lane); continue; } r -= I_OUT;
            if (r < I_UP) { p0_transpose_item<2>(args.in[I_WUP], 1024, 5632, Wup_t, scr, r, lane); continue; } r -= I_UP;
            p0_transpose_item<0>(args.in[I_WDOWN], 2816, 1024, Wdown_t, scr, r, lane);
        }
        for (size_t i = gtid; i < (size_t)96 * 1024 / 8; i += NGT) ((v4u*)(Win_t + (size_t)672 * 1024))[i] = (v4u){0u, 0u, 0u, 0u};
        { auto xrow = [=](int m) { return m < MP ? xp + (size_t)m * DM : xs + (size_t)(m - MP) * DM; };
          for (int m = gw; m < MTOK; m += 4 * NGW) rms_rows_to_bf16<4>(xrow, m, NGW, MTOK, args.in[I_ATTN_NORM], XN, lane); }
        { const float* c = args.in[I_CKV]; bf16* dst = A3 + (size_t)MTOK * KVLORA;
          for (size_t i = gtid; i < (size_t)NSB * PAST * KVLORA / 8; i += NGT) { const f32x4 a = ((const f32x4*)c)[2 * i], b = ((const f32x4*)c)[2 * i + 1];
              v4u o; o.x = pk2(a.x, a.y); o.y = pk2(a.z, a.w); o.z = pk2(b.x, b.y); o.w = pk2(b.z, b.w); ((v4u*)dst)[i] = o; } }
        for (size_t i = gtid; i < (size_t)TP * 16; i += NGT) { const int pos = (int)(i >> 4), k = (int)(i & 15);
            double inv = 1.0; for (int j = 0; j < k; ++j) inv *= 0.56234132519034908039;
            const float ang = (float)pos * (float)inv; float sn, cs; sincos_acc(ang, sn, cs); ropec[i] = cs; ropes[i] = sn; }
    }
    GRID_BAR();

    {
        pg8::Gemm g{XN, Win_t, MTOK, NIN_PAD, 1024}; pg8::StaticOrder S; S.init(MTOK, NIN_PAD, G, bx);
        pg8::EpiInProj E{PROJ, U};
        pg8::gemm_phase<pg8::EpiInProj, pg8::StaticOrder, true, true>(lds, g, S, E);
    }
    GRID_BAR();

    {
        PHASE_IDS();
        const float* qn = args.in[I_QNORM]; const float* kvn = args.in[I_KVNORM];
        const f32x4 z4 = {0.f, 0.f, 0.f, 0.f};
        const bool lq = lane < 48, lk = lane < 32, lp = lane < 8;
        const f32x4 gq0 = lq ? *(const f32x4*)(qn + 8 * lane) : z4, gq1 = lq ? *(const f32x4*)(qn + 8 * lane + 4) : z4;
        const f32x4 gk0 = lk ? *(const f32x4*)(kvn + 8 * lane) : z4, gk1 = lk ? *(const f32x4*)(kvn + 8 * lane + 4) : z4;
        constexpr int P2R = 4;
        for (int mA = gw; mA < MTOK; mA += P2R * NGW) {
            f32x4 q0[P2R], q1[P2R], k0[P2R], k1[P2R], pe[P2R];
#pragma unroll
            for (int rr = 0; rr < P2R; ++rr) { const int mr = mA + rr * NGW; const float* pr = PROJ + (size_t)(mr < MTOK ? mr : mA) * 768;
                q0[rr] = lq ? *(const f32x4*)(pr + 8 * lane) : z4; q1[rr] = lq ? *(const f32x4*)(pr + 8 * lane + 4) : z4;
                k0[rr] = lk ? *(const f32x4*)(pr + 384 + 8 * lane) : z4; k1[rr] = lk ? *(const f32x4*)(pr + 384 + 8 * lane + 4) : z4;
                pe[rr] = lp ? *(const f32x4*)(pr + 640 + 4 * lane) : z4; }
#pragma unroll
            for (int rr = 0; rr < P2R; ++rr) {
                const int m = (mA + rr * NGW < MTOK) ? mA + rr * NGW : mA;
                const f32x4 a0 = q0[rr], a1 = q1[rr], b0 = k0[rr], b1 = k1[rr];
                const float s = (a0.x * a0.x + a0.y * a0.y) + (a0.z * a0.z + a0.w * a0.w) + (a1.x * a1.x + a1.y * a1.y) + (a1.z * a1.z + a1.w * a1.w);
                const float s2 = (b0.x * b0.x + b0.y * b0.y) + (b0.z * b0.z + b0.w * b0.w) + (b1.x * b1.x + b1.y * b1.y) + (b1.z * b1.z + b1.w * b1.w);
                const float rq = 1.f / sqrtf(wave_sum(s) * (1.f / 384.f) + EPS), rk = 1.f / sqrtf(wave_sum(s2) * (1.f / 256.f) + EPS);
                if (lq) { const f32x4 y0 = a0 * rq * gq0, y1 = a1 * rq * gq1; v4u o; o.x = pk2(y0.x, y0.y); o.y = pk2(y0.z, y0.w); o.z = pk2(y1.x, y1.y); o.w = pk2(y1.z, y1.w);
                    *(v4u*)(CQN + (size_t)m * QLORA + 8 * lane) = o; }
                if (lk) { const f32x4 y0 = b0 * rk * gk0, y1 = b1 * rk * gk1;
                    float* ock = (m < MP) ? out + O_CKVP + (size_t)m * KVLORA : out + O_CKVS + (size_t)(m - MP) * KVLORA;
                    *(f32x4*)(ock + 8 * lane) = y0; *(f32x4*)(ock + 8 * lane + 4) = y1;
                    v4u o; o.x = pk2(y0.x, y0.y); o.y = pk2(y0.z, y0.w); o.z = pk2(y1.x, y1.y); o.w = pk2(y1.z, y1.w);
                    *(v4u*)(A3 + (size_t)m * KVLORA + 8 * lane) = o; }
                if (lp) { float* okp = (m < MP) ? out + O_KPEP + (size_t)m * ROPE : out + O_KPES + (size_t)(m - MP) * ROPE; *(f32x4*)(okp + 4 * lane) = pe[rr]; }
            }
        }
        for (int r = gw; r < (NPB + NSB) * 30; r += NGW) {
            const int sq = r / 30, i = r % 30;
            const float* src; float* dst;
            if (sq < NPB) { src = U + (size_t)(sq * TP + TP - 30 + i) * CONVCH; dst = out + O_CONVP + (size_t)(sq * 30 + i) * CONVCH; }
            else { const int b = sq - NPB; src = U + (size_t)(MP + b * TS + TS - 30 + i) * CONVCH; dst = out + O_CONVS + (size_t)(b * 30 + i) * CONVCH; }
#pragma unroll
            for (int j = 0; j < 2; ++j) ((f32x4*)dst)[64 * j + lane] = ((const f32x4*)src)[64 * j + lane];
        }
    }
    GRID_BAR();

    {
        { pg8::Gemm g{CQN, Wuq_t, MTOK, 768, 384}; pg8::StaticOrder S; S.init(MTOK, 768, G, (G == 256) ? (bx + 240) % 256 : bx);
          pg8::EpiBf16 E{Qb, 768, 0, 0};
          pg8::gemm_phase<pg8::EpiBf16, pg8::StaticOrder, true, true>(lds, g, S, E); }
        { pg8::Gemm g{A3, Wukv_t, MKV, 1024, 256}; pg8::StaticOrder S; S.init(MKV, 1024, G, bx);
          pg8::EpiKV E{Kbuf, Vbuf, out + O_KPEP, out + O_KPES, args.in[I_KPE], args.in[I_QKNK], ropec, ropes};
          pg8::gemm_phase<pg8::EpiKV, pg8::StaticOrder, true, true>(lds, g, S, E); }
    }
    GRID_BAR();

    {
        const float* gq = args.in[I_QKNQ]; const float* gkk = args.in[I_QKNK];
        if (G == 256) {
            const int bh = vcu >> 4, s = vcu & 15;
            const int b = bh >> 3, h = bh & 7;
            for (int i = 0; i < 4; ++i) {
                const int qb = (i == 0) ? 63 - s : (i == 1) ? 32 + s : (i == 2) ? 31 - s : s;
                const size_t row0 = (size_t)b * TP + (size_t)qb * 256;
                att::attn_unit(lds, Qb + row0 * 768 + h * HD, Kbuf + (size_t)bh * TP * HD, Vbuf + (size_t)bh * TP * VD, MIX + row0 * 1024 + h * VD, qb * 256, 256, gq, gkk, ropec, ropes);
            }
            if (vcu < NSB * NH) {
                const int sb = vcu >> 3, sh = vcu & 7;
                const size_t row0 = (size_t)MP + (size_t)sb * TS;
                att::attn_unit(lds, Qb + row0 * 768 + sh * HD, Kbuf + ((size_t)NPB * NH * TP + (size_t)vcu * TKS) * HD, Vbuf + ((size_t)NPB * NH * TP + (size_t)vcu * TKS) * VD,
                               MIX + row0 * 1024 + sh * VD, PAST, TS, gq, gkk, ropec, ropes);
            }
        } else {
            for (int u = vcu; u < NPB * NH * 64 + NSB * NH; u += G) {
                if (u < NPB * NH * 64) { const int bh = u >> 6, qb = u & 63, b = bh >> 3, h = bh & 7; const size_t row0 = (size_t)b * TP + (size_t)qb * 256;
                    att::attn_unit(lds, Qb + row0 * 768 + h * HD, Kbuf + (size_t)bh * TP * HD, Vbuf + (size_t)bh * TP * VD, MIX + row0 * 1024 + h * VD, qb * 256, 256, gq, gkk, ropec, ropes); }
                else { const int v = u - NPB * NH * 64; const int sb = v >> 3, sh = v & 7; const size_t row0 = (size_t)MP + (size_t)sb * TS;
                    att::attn_unit(lds, Qb + row0 * 768 + sh * HD, Kbuf + ((size_t)NPB * NH * TP + (size_t)v * TKS) * HD, Vbuf + ((size_t)NPB * NH * TP + (size_t)v * TKS) * VD,
                                   MIX + row0 * 1024 + sh * VD, PAST, TS, gq, gkk, ropec, ropes); }
            }
        }
        __syncthreads();
        {
            PHASE_IDS();
            const int c = tid;
            float w[CONVK];
#pragma unroll
            for (int k = 0; k < CONVK; ++k) w[k] = args.in[I_CONVW][k * CONVCH + c];
            const float bias = args.in[I_CONVB][c], gn = args.in[I_CONVN][c];
            LAS float* red = (LAS float*)lds;
            LAS float* rsd = red + 128;
            constexpr int TB = 16, NITEM = NPB * (TP / TB) + NSB * (TS / TB);
            static_assert(NITEM == 2112, "conv item deal");
            const int nmine = (vcu >= 128 || G != 256) ? 11 : (vcu < 64 ? 6 : 5);
            for (int k = 0; k < (G == 256 ? nmine : (NITEM + G - 1) / G); ++k) {
                const int it = (G != 256) ? vcu + k * G : (vcu >= 128 ? (vcu - 128) * 11 + k : 1408 + vcu + 128 * k);
                if (it >= NITEM) break;
                const float* ubase; const float* hist; size_t mrow0; int t0;
                if (it < NPB * (TP / TB)) { const int b = it / (TP / TB); t0 = (it % (TP / TB)) * TB; mrow0 = (size_t)b * TP; hist = nullptr; }
                else { const int j = it - NPB * (TP / TB); const int b = j / (TS / TB); t0 = (j % (TS / TB)) * TB; mrow0 = (size_t)MP + (size_t)b * TS; hist = args.in[I_SCONV] + (size_t)b * 30 * CONVCH; }
                ubase = U + mrow0 * CONVCH;
                float win[TB + 30];
#pragma unroll
                for (int i = 0; i < TB + 30; ++i) { const int t = t0 - 30 + i;
                    win[i] = (t >= 0) ? ubase[(size_t)t * CONVCH + c] : (hist ? hist[(30 + t) * CONVCH + c] : 0.f); }
                float y[TB];
#pragma unroll
                for (int j = 0; j < TB; ++j) { float a = bias;
#pragma unroll
                    for (int k = 0; k < CONVK; ++k) a += w[k] * win[j + k];
                    y[j] = a; }
                float z8[8], z4[4], z2[2], z1;
                { const bool up = (lane & 32) != 0;
#pragma unroll
                  for (int j = 0; j < 8; ++j) { const float lo = y[j] * y[j], hi = y[j + 8] * y[j + 8]; const float keep = up ? hi : lo, send = up ? lo : hi; z8[j] = keep + __shfl_xor(send, 32); } }
                { const bool up = (lane & 16) != 0;
#pragma unroll
                  for (int j = 0; j < 4; ++j) { const float keep = up ? z8[j + 4] : z8[j], send = up ? z8[j] : z8[j + 4]; z4[j] = keep + __shfl_xor(send, 16); } }
                { const bool up = (lane & 8) != 0;
#pragma unroll
                  for (int j = 0; j < 2; ++j) { const float keep = up ? z4[j + 2] : z4[j], send = up ? z4[j] : z4[j + 2]; z2[j] = keep + __shfl_xor(send, 8); } }
                { const bool up = (lane & 4) != 0; const float keep = up ? z2[1] : z2[0], send = up ? z2[0] : z2[1]; z1 = keep + __shfl_xor(send, 4); }
                z1 += __shfl_xor(z1, 2); z1 += __shfl_xor(z1, 1);
                if ((lane & 3) == 0) red[wave * 16 + (lane >> 2)] = z1;
                __syncthreads();
                if (tid < 16) { float tot = 0.f;
#pragma unroll
                    for (int w8 = 0; w8 < 8; ++w8) tot += red[w8 * 16 + tid];
                    rsd[tid] = 1.f / sqrtf(tot * (1.f / 512.f) + EPS); }
                __syncthreads();
#pragma unroll
                for (int j = 0; j < TB; ++j) { const float v = y[j] * rsd[j] * gn;
                    MIX[(mrow0 + t0 + j) * 1024 + 512 + c] = (bf16)f2bf(v * __builtin_amdgcn_rcpf(1.f + __expf(-v))); }
            }
        }
    }
    GRID_BAR();

    {
        pg8::Gemm g{MIX, Wout_t, MTOK, 1024, 1024}; pg8::StaticOrder S; S.init(MTOK, 1024, G, bx);
        pg8::EpiRes<false> E{xp, xs, out};
        pg8::gemm_phase<pg8::EpiRes<false>, pg8::StaticOrder, true, true>(lds, g, S, E);
    }
    GRID_BAR();

    { PHASE_IDS(); auto orow = [=](int m) { return (const float*)out + (size_t)m * DM; };
      for (int m = gw; m < MTOK; m += 4 * NGW) rms_rows_to_bf16<4>(orow, m, NGW, MTOK, args.in[I_FFNN], XN, lane); }
    GRID_BAR();

    {
        pg8::Gemm g{XN, Wup_t, MTOK, 2 * DFF, 1024}; pg8::StaticOrder S; S.init(MTOK, 2 * DFF, G, bx);
        pg8::EpiUp E{UPG, AUXA, AUXG, args.in[I_FCW], args.in[I_FCB]};
        pg8::gemm_phase<pg8::EpiUp, pg8::StaticOrder, true, true>(lds, g, S, E);
    }
    GRID_BAR();

    {
        PHASE_IDS();
        const float* fw = args.in[I_FCW]; const float* fb = args.in[I_FCB];
        constexpr int NGRP = MTOK / 64, NV4 = DFF / 4;
        for (size_t idx = gtid; idx < (size_t)NGRP * 2 * NV4; idx += NGT) {
            const int g = (int)(idx / (2 * NV4)), rem = (int)(idx % (2 * NV4)), t = rem / NV4, c4 = (rem % NV4) * 4;
            const bool start = (g < MP / 64) ? ((g % (TP / 64)) == 0) : true;
            const float* hist = (g < MP / 64) ? nullptr : args.in[I_SFFN] + (size_t)(g - MP / 64) * 2 * DFF;
            const f32x4 z = {0.f, 0.f, 0.f, 0.f};
            const f32x4 at = *(const f32x4*)(AUXA + ((size_t)g * 4 + t) * DFF + c4), gt = *(const f32x4*)(AUXG + ((size_t)g * 2 + t) * DFF + c4);
            f32x4 am1, am2;
            const f32x4 h1 = start ? (hist ? *(const f32x4*)(hist + DFF + c4) : z) : *(const f32x4*)(AUXA + ((size_t)(g - 1) * 4 + 3) * DFF + c4);
            if (t == 0) { am1 = h1; am2 = start ? (hist ? *(const f32x4*)(hist + c4) : z) : *(const f32x4*)(AUXA + ((size_t)(g - 1) * 4 + 2) * DFF + c4); }
            else { am1 = *(const f32x4*)(AUXA + ((size_t)g * 4) * DFF + c4); am2 = h1; }
            const f32x4 w0 = *(const f32x4*)(fw + c4), w1 = *(const f32x4*)(fw + DFF + c4), w2 = *(const f32x4*)(fw + 2 * DFF + c4), bb = *(const f32x4*)(fb + c4);
            float hv[4];
#pragma unroll
            for (int e = 0; e < 4; ++e) { const float y = w0[e] * am2[e] + w1[e] * am1[e] + w2[e] * at[e] + bb[e]; hv[e] = y * sigmoidf_(y) * gt[e]; }
            v2u o; o.x = pk2(hv[0], hv[1]); o.y = pk2(hv[2], hv[3]);
            *(v2u*)(UPG + ((size_t)g * 64 + t) * DFF + c4) = o;
        }
        for (size_t idx = gtid; idx < (size_t)(NPB + NSB) * 2 * NV4; idx += NGT) {
            const int sq = (int)(idx / (2 * NV4)), rem = (int)(idx % (2 * NV4)), k = rem / NV4, c4 = (rem % NV4) * 4;
            const int g = (sq < NPB) ? (sq + 1) * (TP / 64) - 1 : MP / 64 + (sq - NPB);
            float* dst = (sq < NPB) ? out + O_FFNP + ((size_t)sq * 2 + k) * DFF + c4 : out + O_FFNS + ((size_t)(sq - NPB) * 2 + k) * DFF + c4;
            *(f32x4*)dst = *(const f32x4*)(AUXA + ((size_t)g * 4 + 2 + k) * DFF + c4);
        }
    }
    GRID_BAR();

    {
        pg8::Gemm g{UPG, Wdown_t, MTOK, 1024, DFF}; pg8::StaticOrder S; S.init(MTOK, 1024, G, bx);
        pg8::EpiRes<true> E{nullptr, nullptr, out};
        pg8::gemm_phase<pg8::EpiRes<true>, pg8::StaticOrder, true, true>(lds, g, S, E);
    }
}

extern "C" void kernel_launch(void* const* d_in, const int* in_sizes, int n_in, void* d_out, int out_size, void* d_ws, size_t ws_size, hipStream_t stream) {
    static int grid = 0;
    if (grid == 0) {
        if (n_in != 23 || in_sizes[0] != MP * DM || (size_t)out_size != O_TOTAL || ws_size < WS_END) {
            fprintf(stderr, "kernel_launch: unexpected shapes: n_in %d in0 %d out %d ws %zu; nothing launched\n", n_in, n_in > 0 ? in_sizes[0] : -1, out_size, ws_size); grid = -1; return; }
        int dev = 0, cus = 0, per_cu = 0;
        if (hipGetDevice(&dev) != hipSuccess || hipDeviceGetAttribute(&cus, hipDeviceAttributeMultiprocessorCount, dev) != hipSuccess) { grid = -1; return; }
        if (hipFuncSetAttribute((const void*)mk_fwd, hipFuncAttributeMaxDynamicSharedMemorySize, LDS_BYTES) != hipSuccess) { fprintf(stderr, "kernel_launch: hipFuncSetAttribute failed\n"); grid = -1; return; }
        if (hipOccupancyMaxActiveBlocksPerMultiprocessor(&per_cu, (const void*)mk_fwd, NWAVES * 64, LDS_BYTES) != hipSuccess || per_cu < 1) {
            fprintf(stderr, "kernel_launch: occupancy query reports %d workgroups per CU\n", per_cu); (void)hipGetLastError(); per_cu = 1; }
        grid = cus;
    }
    if (grid < 0) return;
    if (hipMemsetAsync((char*)d_ws + WS_CTL, 0, CTL_ZERO_BYTES, stream) != hipSuccess) { fprintf(stderr, "kernel_launch: hipMemsetAsync failed\n"); return; }
    Args a{};
    for (int i = 0; i < 23; ++i) a.in[i] = (const float*)d_in[i];
    a.out = (float*)d_out; a.ws = (unsigned char*)d_ws;
    void* kargs[] = {&a};
    const hipError_t e = hipLaunchCooperativeKernel((const void*)mk_fwd, dim3(grid), dim3(NWAVES * 64), kargs, LDS_BYTES, stream);
    if (e != hipSuccess) fprintf(stderr, "kernel_launch: cooperative launch failed: %s (grid %d)\n", hipGetErrorString(e), grid);
}
```

```cpp
#include <hip/hip_runtime.h>
#include <hip/hip_cooperative_groups.h>
#include <cstdio>
#include <cstdint>
namespace cg = cooperative_groups;
namespace pg8 {
#define PG8_LAS __attribute__((address_space(3)))
typedef unsigned short bf16_t;
typedef short bf16x8 __attribute__((ext_vector_type(8)));
typedef float f32x4 __attribute__((ext_vector_type(4)));
typedef unsigned u32x4 __attribute__((ext_vector_type(4)));
constexpr int BM = 256, BK = 64, HALF = 128, HTB = HALF * BK * 2  , STAGE_BYTES = 8 * HTB, NXCD = 8, WGM = 8;

__host__ __device__ __forceinline__ int lds_byte(int r, int c) { const int st = (r >> 4) * 2 + (c >> 5), rr = r & 15, cc = c & 31, ob = rr * 64 + cc * 2; return st * 1024 + (ob ^ (((ob >> 9) & 1) << 5)); }
__host__ __device__ __forceinline__ void stage_rc(int b, int& R, int& C) { const int st = b / 1024, sb = b % 1024, swz = sb ^ (((sb >> 9) & 1) << 5); R = (st >> 1) * 16 + swz / 64; C = (st & 1) * 32 + (swz % 64) / 2; }
__host__ __device__ __forceinline__ int perm32(int rho) { const int n = rho >> 4, i = rho & 15; return 8 * (i >> 2) + 4 * n + (i & 3); }

struct Unit { int pm, pn; };
struct Gemm { const bf16_t* A; const bf16_t* Bt; int M, N, K; };

struct StaticOrder {
    int nM, nN, nwg, G, c;
    __host__ __device__ void init(int M, int N, int G_, int c_) { nM = M / BM; nN = N / BM; nwg = nM * nN; G = G_; c = c_; }
    __host__ __device__ bool next(int i, Unit& u) const {
        const long L = (long)i * G + c; if (L >= nwg) return false;
        int wgid = (int)L; { const int q = nwg / NXCD, r = nwg % NXCD, xcd = wgid % NXCD, off = wgid / NXCD; wgid = (xcd < r ? xcd * (q + 1) : r * (q + 1) + (xcd - r) * q) + off; }
        const int nig = WGM * nN, gid = wgid / nig, fm = gid * WGM, gsz = (nM - fm) < WGM ? (nM - fm) : WGM;
        u.pm = fm + ((wgid % nig) % gsz); u.pn = (wgid % nig) / gsz; return true;
    }
    __device__ __forceinline__ void a_ready(const Unit&) const {}
    __device__ __forceinline__ void done(const Unit&) const {}
};


__device__ __forceinline__ unsigned cvt_pk_bf16(float lo, float hi) { unsigned r; asm volatile("v_cvt_pk_bf16_f32 %0, %1, %2" : "=v"(r) : "v"(lo), "v"(hi)); return r; }

struct EpiBf16 {
    static constexpr bool PERM = true, AFTER_DRAIN = false;
    bf16_t* O; int ldc; int split_cols; size_t split_stride;
    __device__ __forceinline__ void operator()(const f32x4 (&acc)[2][2][4][2], const Unit& u, int wr, int wc, int fr, int fq) const {
        const int row0 = u.pm * BM + wr * 64 + fr; int colt = u.pn * BM; bf16_t* base = O;
        if (split_cols) { const int t = colt / split_cols; base += (size_t)t * split_stride; colt -= t * split_cols; }
        const int col0 = colt + wc * 32 + 8 * fq;
#pragma unroll
        for (int ai = 0; ai < 2; ++ai)
#pragma unroll
            for (int m = 0; m < 4; ++m) { bf16_t* rowp = base + (size_t)(row0 + ai * HALF + m * 16) * ldc + col0;
#pragma unroll
                for (int bj = 0; bj < 2; ++bj) { const f32x4 v0 = acc[ai][bj][m][0], v1 = acc[ai][bj][m][1];
                    u32x4 w; w.x = cvt_pk_bf16(v0[0], v0[1]); w.y = cvt_pk_bf16(v0[2], v0[3]); w.z = cvt_pk_bf16(v1[0], v1[1]); w.w = cvt_pk_bf16(v1[2], v1[3]);
                    *(u32x4*)(rowp + bj * HALF) = w; } }
    }
};

struct EpiInProj {
    static constexpr bool PERM = true, AFTER_DRAIN = false;
    float* PROJ; float* U;
    __device__ __forceinline__ void operator()(const f32x4 (&acc)[2][2][4][2], const Unit& u, int wr, int wc, int fr, int fq) const {
        const int row0 = u.pm * BM + wr * 64 + fr;
        if (u.pn < 3) {
            const int col0 = u.pn * BM + wc * 32 + 8 * fq;
#pragma unroll
            for (int ai = 0; ai < 2; ++ai)
#pragma unroll
                for (int m = 0; m < 4; ++m) { float* rowp = PROJ + (size_t)(row0 + ai * HALF + m * 16) * 768 + col0;
#pragma unroll
                    for (int bj = 0; bj < 2; ++bj) { *(f32x4*)(rowp + bj * HALF) = acc[ai][bj][m][0]; *(f32x4*)(rowp + bj * HALF + 4) = acc[ai][bj][m][1]; } }
        } else {
            const int ch0 = (u.pn - 3) * 128 + 16 * wc + 4 * fq;
#pragma unroll
            for (int ai = 0; ai < 2; ++ai)
#pragma unroll
                for (int m = 0; m < 4; ++m) { float* rowp = U + (size_t)(row0 + ai * HALF + m * 16) * 512 + ch0;
#pragma unroll
                    for (int bj = 0; bj < 2; ++bj) { const f32x4 a = acc[ai][bj][m][0], g = acc[ai][bj][m][1]; f32x4 o;
#pragma unroll
                        for (int e = 0; e < 4; ++e) o[e] = a[e] * __builtin_amdgcn_rcpf(1.f + __expf(-g[e]));
                        *(f32x4*)(rowp + bj * 64) = o; } }
        }
    }
};

struct EpiUp {
    static constexpr bool PERM = true, AFTER_DRAIN = false;
    bf16_t* H; float* AUXA; float* AUXG; const float* fw; const float* fb;
    __device__ __forceinline__ void operator()(const f32x4 (&acc)[2][2][4][2], const Unit& u, int wr, int wc, int fr, int fq) const {
        const int lane = fq * 16 + fr, src1 = (lane & 48) | ((fr + 15) & 15), src2 = (lane & 48) | ((fr + 14) & 15);
        const int ch0 = u.pn * 128 + 16 * wc + 4 * fq;
#pragma unroll
        for (int bj = 0; bj < 2; ++bj) {
            const int ch = ch0 + 64 * bj;
            const f32x4 w0 = *(const f32x4*)(fw + ch), w1 = *(const f32x4*)(fw + 2816 + ch), w2 = *(const f32x4*)(fw + 2 * 2816 + ch), bb = *(const f32x4*)(fb + ch);
#pragma unroll
            for (int ai = 0; ai < 2; ++ai) {
                const int grp = 4 * u.pm + 2 * ai + wr; const size_t row0 = (size_t)u.pm * BM + ai * HALF + wr * 64 + fr;
                f32x4 hv[4];
#pragma unroll
                for (int e = 0; e < 4; ++e) {
                    float r1[4], r2[4];
#pragma unroll
                    for (int m = 0; m < 4; ++m) { r1[m] = __shfl(acc[ai][bj][m][0][e], src1); r2[m] = __shfl(acc[ai][bj][m][0][e], src2); }
#pragma unroll
                    for (int m = 0; m < 4; ++m) {
                        const float p1 = (fr >= 1) ? r1[m] : r1[m > 0 ? m - 1 : 0], p2 = (fr >= 2) ? r2[m] : r2[m > 0 ? m - 1 : 0];
                        const float y = w0[e] * p2 + w1[e] * p1 + w2[e] * acc[ai][bj][m][0][e] + bb[e];
                        hv[m][e] = y * __builtin_amdgcn_rcpf(1.f + __expf(-y)) * acc[ai][bj][m][1][e];
                    }
                }
#pragma unroll
                for (int m = 0; m < 4; ++m) if (m > 0 || fr >= 2) {
                    unsigned lo = cvt_pk_bf16(hv[m][0], hv[m][1]), hi = cvt_pk_bf16(hv[m][2], hv[m][3]);
                    typedef unsigned u32x2 __attribute__((ext_vector_type(2)));
                    *(u32x2*)(H + (row0 + 16 * m) * 2816 + ch) = (u32x2){lo, hi};
                }
                if (fr < 2) { *(f32x4*)(AUXA + ((size_t)grp * 4 + fr) * 2816 + ch) = acc[ai][bj][0][0]; *(f32x4*)(AUXG + ((size_t)grp * 2 + fr) * 2816 + ch) = acc[ai][bj][0][1]; }
                if (fr >= 14) *(f32x4*)(AUXA + ((size_t)grp * 4 + 2 + (fr - 14)) * 2816 + ch) = acc[ai][bj][3][0];
            }
        }
    }
};

struct EpiKV {
    static constexpr bool PERM = true, AFTER_DRAIN = false;
    bf16_t* Kb; bf16_t* Vb; const float* kpe_p; const float* kpe_s; const float* kpe_past; const float* gk; const float* ropec; const float* ropes;
    __device__ __forceinline__ void operator()(const f32x4 (&acc)[2][2][4][2], const Unit& u, int wr, int wc, int fr_in, int fq_in) const {
        int fr0 = fr_in, fq0 = fq_in; asm volatile("" : "+v"(fr0), "+v"(fq0));
        const int h = 2 * u.pn + (wc >> 1);
        constexpr int TP_ = 16384, MP_ = 32768, MTOK_ = 33792, TKS_ = 2112, PAST_ = 2048; constexpr size_t KSB = (size_t)2 * 8 * TP_;
#pragma unroll
        for (int ai = 0; ai < 2; ++ai)
#pragma unroll
            for (int m = 0; m < 4; ++m) {
                int fr = fr0, fq = fq0; asm volatile("" : "+v"(fr), "+v"(fq) :: "memory");
                const int r = u.pm * BM + ai * HALF + wr * 64 + m * 16 + fr;
                size_t drow; int pos; const float* kpe;
                if (r < MP_) { const int b = r / TP_, t = r % TP_; pos = t; kpe = kpe_p + (size_t)r * 32; drow = (size_t)(b * 8 + h) * TP_ + t; }
                else if (r < MTOK_) { const int rs = r - MP_, b = rs >> 6, t = rs & 63; pos = PAST_ + t; kpe = kpe_s + (size_t)rs * 32; drow = KSB + (size_t)(b * 8 + h) * TKS_ + PAST_ + t; }
                else { const int rr = r - MTOK_, b = rr / PAST_, t = rr % PAST_; pos = t; kpe = kpe_past + (size_t)rr * 32; drow = KSB + (size_t)(b * 8 + h) * TKS_ + t; }
                if (wc & 1) {
                    bf16_t* vd = Vb + drow * 64 + 8 * fq;
#pragma unroll
                    for (int bj = 0; bj < 2; ++bj) { const f32x4 v0 = acc[ai][bj][m][0], v1 = acc[ai][bj][m][1];
                        u32x4 w; w.x = cvt_pk_bf16(v0[0], v0[1]); w.y = cvt_pk_bf16(v0[2], v0[3]); w.z = cvt_pk_bf16(v1[0], v1[1]); w.w = cvt_pk_bf16(v1[2], v1[3]);
                        *(u32x4*)(vd + 32 * bj) = w; }
                } else {
                    const f32x4 pe0 = *(const f32x4*)(kpe + 8 * fq), pe1 = *(const f32x4*)(kpe + 8 * fq + 4);
                    const f32x4 pp0 = *(const f32x4*)(kpe + 8 * (fq ^ 2)), pp1 = *(const f32x4*)(kpe + 8 * (fq ^ 2) + 4);
                    float ss = 0.f;
#pragma unroll
                    for (int bj = 0; bj < 2; ++bj)
#pragma unroll
                        for (int n = 0; n < 2; ++n)
#pragma unroll
                            for (int e = 0; e < 4; ++e) ss += acc[ai][bj][m][n][e] * acc[ai][bj][m][n][e];
#pragma unroll
                    for (int e = 0; e < 4; ++e) ss += pe0[e] * pe0[e] + pe1[e] * pe1[e];
                    ss += __shfl_xor(ss, 16); ss += __shfl_xor(ss, 32);
                    const float rstd = 1.f / sqrtf(ss * (1.f / 96.f) + 1e-6f);
                    bf16_t* kd = Kb + drow * 96 + 8 * fq;
#pragma unroll
                    for (int bj = 0; bj < 2; ++bj) { const f32x4 g0 = *(const f32x4*)(gk + 32 * bj + 8 * fq), g1 = *(const f32x4*)(gk + 32 * bj + 8 * fq + 4);
                        const f32x4 v0 = acc[ai][bj][m][0] * rstd * g0, v1 = acc[ai][bj][m][1] * rstd * g1;
                        u32x4 w; w.x = cvt_pk_bf16(v0[0], v0[1]); w.y = cvt_pk_bf16(v0[2], v0[3]); w.z = cvt_pk_bf16(v1[0], v1[1]); w.w = cvt_pk_bf16(v1[2], v1[3]);
                        *(u32x4*)(kd + 32 * bj) = w; }
                    const f32x4 ge0 = *(const f32x4*)(gk + 64 + 8 * fq), ge1 = *(const f32x4*)(gk + 64 + 8 * fq + 4);
                    const f32x4 gp0 = *(const f32x4*)(gk + 64 + 8 * (fq ^ 2)), gp1 = *(const f32x4*)(gk + 64 + 8 * (fq ^ 2) + 4);
                    const float* cs = ropec + (size_t)pos * 16 + 8 * (fq & 1); const float* sn = ropes + (size_t)pos * 16 + 8 * (fq & 1);
                    const f32x4 c0 = *(const f32x4*)cs, c1 = *(const f32x4*)(cs + 4), s0 = *(const f32x4*)sn, s1 = *(const f32x4*)(sn + 4);
                    const float sg = (fq < 2) ? -1.f : 1.f;
                    const f32x4 o0 = (pe0 * ge0 * c0 + (pp0 * gp0 * s0) * sg) * rstd, o1 = (pe1 * ge1 * c1 + (pp1 * gp1 * s1) * sg) * rstd;
                    u32x4 w; w.x = cvt_pk_bf16(o0[0], o0[1]); w.y = cvt_pk_bf16(o0[2], o0[3]); w.z = cvt_pk_bf16(o1[0], o1[1]); w.w = cvt_pk_bf16(o1[2], o1[3]);
                    *(u32x4*)(kd + 64) = w;
                }
            }
    }
};

template <bool INPLACE> struct EpiRes {
    static constexpr bool PERM = true, AFTER_DRAIN = false;
    const float* xp; const float* xs; float* out;
    __device__ __forceinline__ void operator()(const f32x4 (&acc)[2][2][4][2], const Unit& u, int wr, int wc, int fr, int fq) const {
        const int row0 = u.pm * BM + wr * 64 + fr; const int col0 = u.pn * BM + wc * 32 + 8 * fq;
        const float* rbase = INPLACE ? (const float*)out : (u.pm * BM < 32768 ? xp : xs - (size_t)32768 * 1024);
#pragma unroll
        for (int ai = 0; ai < 2; ++ai)
#pragma unroll
            for (int m = 0; m < 4; ++m) { const size_t off = (size_t)(row0 + ai * HALF + m * 16) * 1024 + col0;
#pragma unroll
                for (int bj = 0; bj < 2; ++bj) { const f32x4 r0 = *(const f32x4*)(rbase + off + bj * HALF), r1 = *(const f32x4*)(rbase + off + bj * HALF + 4);
                    *(f32x4*)(out + off + bj * HALF) = r0 + acc[ai][bj][m][0]; *(f32x4*)(out + off + bj * HALF + 4) = r1 + acc[ai][bj][m][1]; } }
    }
};

template <class Epi, class Sched, bool ALIGN_EPI = false, bool SP2 = false>
__device__ __forceinline__ void gemm_phase(PG8_LAS unsigned char* lds, const Gemm g, const Sched& S, const Epi& E) {
    int tid_ = threadIdx.x; asm volatile("" : "+v"(tid_));
    const int tid = tid_, wid = __builtin_amdgcn_readfirstlane(tid >> 6), lane = tid & 63, wr = wid >> 2, wc = wid & 3, fr = lane & 15, fq = lane >> 4;
    int K_ = g.K; asm volatile("" : "+s"(K_));
    const int K = K_, nt = K / BK;
    unsigned voffA[2], voffB[2];
#pragma unroll
    for (int i = 0; i < 2; ++i) { int R, C; stage_rc(tid * 16 + i * 8192, R, C); const int Rb = Epi::PERM ? ((R & ~31) + perm32(R & 31)) : R;
        voffA[i] = (unsigned)(R * K + C) * 2u; voffB[i] = (unsigned)(Rb * K + C) * 2u; }
    const size_t kstep = (size_t)(BK * 2);
    const size_t hstep = (size_t)HALF * K * 2;
    const size_t tstep = 2 * hstep;
    const unsigned ldsw = (unsigned)wid * 1024u;
    const int aoff = lds_byte(wr * 64 + fr, fq * 8), boff = lds_byte(wc * 32 + fr, fq * 8);
#define PG8_SA(b, h) (((b) * 2 + (h)) * HTB)
#define PG8_SB(b, h) ((4 + (b) * 2 + (h)) * HTB)
#define PG8_STAGE(bufoff, gbase, voff) do { _Pragma("unroll") for (int _i = 0; _i < 2; ++_i) \
        __builtin_amdgcn_global_load_lds((const unsigned*)((const char*)(gbase) + (voff)[_i]), (PG8_LAS unsigned*)(lds + (bufoff) + ldsw + _i * 8192), 16, 0, 0); } while (0)
#define PG8_LDA(dst, b, h) do { _Pragma("unroll") for (int m = 0; m < 4; ++m) _Pragma("unroll") for (int k = 0; k < 2; ++k) dst[m][k] = *(const PG8_LAS bf16x8*)(lds + PG8_SA(b, h) + aoff + m * 2048 + k * 1024); } while (0)
#define PG8_LDB(dst, b, h) do { _Pragma("unroll") for (int n = 0; n < 2; ++n) _Pragma("unroll") for (int k = 0; k < 2; ++k) dst[n][k] = *(const PG8_LAS bf16x8*)(lds + PG8_SB(b, h) + boff + n * 2048 + k * 1024); } while (0)
#define PG8_MMA(ai, bj, At, Bt) do { __builtin_amdgcn_s_setprio(1); _Pragma("unroll") for (int m = 0; m < 4; ++m) _Pragma("unroll") for (int n = 0; n < 2; ++n) _Pragma("unroll") for (int k = 0; k < 2; ++k) \
        acc[ai][bj][m][n] = __builtin_amdgcn_mfma_f32_16x16x32_bf16(Bt[n][k], At[m][k], acc[ai][bj][m][n], 0, 0, 0); __builtin_amdgcn_s_setprio(0); } while (0)
#define PG8_WAIT_V(n) asm volatile("s_waitcnt vmcnt(" #n ")" ::: "memory")
#define PG8_WAIT_L(n) asm volatile("s_waitcnt lgkmcnt(" #n ")" ::: "memory")
#define PG8_BAR __builtin_amdgcn_s_barrier()
#define PG8_SCHED __builtin_amdgcn_sched_barrier(0)
    Unit cur, nxt; int ui = 0;
    if (!S.next(0, cur)) return;
    f32x4 acc[2][2][4][2];
#pragma unroll
    for (int a = 0; a < 2; ++a)
#pragma unroll
        for (int b = 0; b < 2; ++b)
#pragma unroll
            for (int m = 0; m < 4; ++m)
#pragma unroll
                for (int n = 0; n < 2; ++n) acc[a][b][m][n] = (f32x4){0.f, 0.f, 0.f, 0.f};
    bf16x8 At[4][2], B0[2][2], B1[2][2];
    const char* cA = (const char*)g.A + (size_t)cur.pm * tstep; const char* cB = (const char*)g.Bt + (size_t)cur.pn * tstep;
    S.a_ready(cur);
    if constexpr (SP2) {
        PG8_STAGE(PG8_SB(0, 0), cB, voffB); PG8_STAGE(PG8_SB(0, 1), cB + hstep, voffB); PG8_STAGE(PG8_SA(0, 0), cA, voffA); PG8_STAGE(PG8_SA(0, 1), cA + hstep, voffA);
        if (wr == 1) PG8_BAR;
        PG8_WAIT_V(2); PG8_BAR;
        PG8_STAGE(PG8_SB(1, 0), cB + kstep, voffB); PG8_STAGE(PG8_SA(1, 0), cA + kstep, voffA); PG8_STAGE(PG8_SB(1, 1), cB + hstep + kstep, voffB);
        PG8_WAIT_V(6); PG8_BAR;
    } else {
        PG8_STAGE(PG8_SB(0, 0), cB, voffB); PG8_STAGE(PG8_SA(0, 0), cA, voffA); PG8_STAGE(PG8_SB(0, 1), cB + hstep, voffB); PG8_STAGE(PG8_SA(0, 1), cA + hstep, voffA);
        if (wr == 1) PG8_BAR;
        PG8_WAIT_V(4); PG8_BAR;
        PG8_STAGE(PG8_SB(1, 0), cB + kstep, voffB); PG8_STAGE(PG8_SA(1, 0), cA + kstep, voffA); PG8_STAGE(PG8_SB(1, 1), cB + hstep + kstep, voffB);
        PG8_WAIT_V(6); PG8_BAR;
    }
    for (;;) {
        const bool has_next = S.next(ui + 1, nxt);
        const char* nA = has_next ? (const char*)g.A + (size_t)nxt.pm * tstep : cA; const char* nB = has_next ? (const char*)g.Bt + (size_t)nxt.pn * tstep : cB;
        for (int t = 0; t < nt; t += 2) {
            const bool last = (t == nt - 2);
            const char* a1 = cA + (size_t)(t + 1) * kstep;
            const char* a2 = last ? nA : cA + (size_t)(t + 2) * kstep; const char* b2 = last ? nB : cB + (size_t)(t + 2) * kstep;
            const char* a3 = a2 + kstep; const char* b3 = b2 + kstep;
            if (last && has_next) S.a_ready(nxt);
            if constexpr (SP2) {
            PG8_LDB(B0, 0, 0); PG8_LDB(B1, 0, 1); PG8_SCHED; PG8_LDA(At, 0, 0); PG8_STAGE(PG8_SA(1, 1), a1 + hstep, voffA);
            PG8_WAIT_V(8); PG8_WAIT_L(0); PG8_BAR; PG8_MMA(0, 0, At, B0); PG8_MMA(0, 1, At, B1); PG8_BAR; PG8_SCHED;
            PG8_LDA(At, 0, 1); PG8_STAGE(PG8_SB(0, 0), b2, voffB); PG8_STAGE(PG8_SB(0, 1), b2 + hstep, voffB); PG8_STAGE(PG8_SA(0, 0), a2, voffA);
            PG8_WAIT_V(8); PG8_WAIT_L(0); PG8_BAR; PG8_MMA(1, 0, At, B0); PG8_MMA(1, 1, At, B1); PG8_BAR; PG8_SCHED;
            PG8_LDB(B0, 1, 0); PG8_LDB(B1, 1, 1); PG8_SCHED; PG8_LDA(At, 1, 0); PG8_STAGE(PG8_SA(0, 1), a2 + hstep, voffA);
            PG8_WAIT_V(8); PG8_WAIT_L(0); PG8_BAR; PG8_MMA(0, 0, At, B0); PG8_MMA(0, 1, At, B1); PG8_BAR; PG8_SCHED;
            PG8_LDA(At, 1, 1); PG8_STAGE(PG8_SB(1, 0), b3, voffB); PG8_STAGE(PG8_SB(1, 1), b3 + hstep, voffB); PG8_STAGE(PG8_SA(1, 0), a3, voffA);
            PG8_WAIT_V(8); PG8_WAIT_L(0); PG8_BAR; PG8_MMA(1, 0, At, B0); PG8_MMA(1, 1, At, B1); PG8_BAR; PG8_SCHED;
            } else {
            PG8_LDB(B0, 0, 0); PG8_SCHED; PG8_LDA(At, 0, 0); PG8_STAGE(PG8_SA(1, 1), a1 + hstep, voffA);
            PG8_WAIT_L(8); PG8_BAR; PG8_WAIT_L(0); PG8_MMA(0, 0, At, B0); PG8_BAR; PG8_SCHED;
            PG8_LDB(B1, 0, 1); PG8_STAGE(PG8_SB(0, 0), b2, voffB);
            PG8_BAR; PG8_WAIT_L(0); PG8_MMA(0, 1, At, B1); PG8_BAR;
            PG8_LDA(At, 0, 1); PG8_STAGE(PG8_SA(0, 0), a2, voffA);
            PG8_BAR; PG8_WAIT_L(0); PG8_MMA(1, 0, At, B0); PG8_BAR; PG8_SCHED;
            PG8_STAGE(PG8_SB(0, 1), b2 + hstep, voffB);
            PG8_WAIT_V(6); PG8_BAR; PG8_MMA(1, 1, At, B1); PG8_BAR;
            PG8_LDB(B0, 1, 0); PG8_SCHED; PG8_LDA(At, 1, 0); PG8_STAGE(PG8_SA(0, 1), a2 + hstep, voffA);
            PG8_WAIT_L(8); PG8_BAR; PG8_WAIT_L(0); PG8_MMA(0, 0, At, B0); PG8_BAR; PG8_SCHED;
            PG8_LDB(B1, 1, 1); PG8_STAGE(PG8_SB(1, 0), b3, voffB);
            PG8_BAR; PG8_WAIT_L(0); PG8_MMA(0, 1, At, B1); PG8_BAR;
            PG8_LDA(At, 1, 1); PG8_STAGE(PG8_SA(1, 0), a3, voffA);
            PG8_BAR; PG8_WAIT_L(0); PG8_MMA(1, 0, At, B0); PG8_BAR; PG8_SCHED;
            PG8_STAGE(PG8_SB(1, 1), b3 + hstep, voffB);
            PG8_WAIT_V(6); PG8_BAR; PG8_MMA(1, 1, At, B1); PG8_BAR;
            }
        }
        if constexpr (ALIGN_EPI) { if (wr == 0) PG8_BAR; }
        if constexpr (!Epi::AFTER_DRAIN) { E(acc, cur, wr, wc, fr, fq); S.done(cur); }
        if (!has_next) break;
#pragma unroll
        for (int a = 0; a < 2; ++a)
#pragma unroll
            for (int b = 0; b < 2; ++b)
#pragma unroll
                for (int m = 0; m < 4; ++m)
#pragma unroll
                    for (int n = 0; n < 2; ++n) acc[a][b][m][n] = (f32x4){0.f, 0.f, 0.f, 0.f};
        cur = nxt; cA = nA; cB = nB; ++ui;
        if constexpr (ALIGN_EPI) { if (wr == 1) PG8_BAR; }
    }
    PG8_WAIT_V(0);
    if constexpr (!ALIGN_EPI) { if (wr == 0) PG8_BAR; }
    PG8_BAR;
    if constexpr (Epi::AFTER_DRAIN) { E.fused(acc, cur, wr, wc, fr, fq, lds, wid, lane); S.done(cur); }
#undef PG8_SA
#undef PG8_SB
#undef PG8_STAGE
#undef PG8_LDA
#undef PG8_LDB
#undef PG8_MMA
#undef PG8_WAIT_V
#undef PG8_WAIT_L
#undef PG8_BAR
#undef PG8_SCHED
}
}

#define LAS __attribute__((address_space(3)))
typedef unsigned short bf16;
typedef unsigned v4u __attribute__((ext_vector_type(4)));
typedef unsigned v2u __attribute__((ext_vector_type(2)));
typedef float f32x4 __attribute__((ext_vector_type(4)));
typedef float f32x16 __attribute__((ext_vector_type(16)));
typedef short bf16x8 __attribute__((ext_vector_type(8)));
typedef short s16x4 __attribute__((ext_vector_type(4)));
typedef float f32x2_t __attribute__((ext_vector_type(2)));
typedef __bf16 bf16x2_t __attribute__((ext_vector_type(2)));

constexpr int NWAVES = 8;
constexpr int DM = 1024, TP = 16384, NPB = 2, TS = 64, NSB = 16, PAST = 2048, TKS = PAST + TS;
constexpr int MP = NPB * TP, MS = NSB * TS, MTOK = MP + MS, MKV = MTOK + NSB * PAST;
constexpr int QLORA = 384, KVLORA = 256, ROPE = 32, CONVCH = 512, CONVK = 31, DFF = 2816, NH = 8, HD = 96, VD = 64;
constexpr int NIN_PAD = 1792;
constexpr float EPS = 1e-6f;
constexpr size_t O_YP = 0, O_YS = 33554432, O_CKVP = 34603008, O_KPEP = 42991616, O_CONVP = 44040192, O_FFNP = 44070912,
                 O_CKVS = 44082176, O_KPES = 44344320, O_CONVS = 44377088, O_FFNS = 44622848, O_TOTAL = 44712960;
constexpr size_t MiB = 1u << 20;
constexpr size_t WS_CTL = 0, CTL_ZERO_BYTES = 65536; constexpr int CW_BAR = 4096;
constexpr size_t WS_WIN = 1 * MiB, WS_WUQ = 5 * MiB, WS_WUKV = 6 * MiB, WS_WOUT = 7 * MiB, WS_WUP = 9 * MiB, WS_WDOWN = 20 * MiB, WS_ROPEC = 26 * MiB, WS_ROPES = 27 * MiB;
constexpr size_t WS_XN = 32 * MiB;
constexpr size_t WS_V = 32 * MiB;
constexpr size_t WS_MIX = 98 * MiB;
constexpr size_t WS_PROJ = 164 * MiB;
constexpr size_t WS_A3 = 331 * MiB;
constexpr size_t WS_CQN = 364 * MiB;
constexpr size_t WS_Q = 164 * MiB;
constexpr size_t WS_U = 164 * MiB + 100 * MiB;
constexpr size_t WS_K = 404 * MiB;
constexpr size_t WS_AUXA = 98 * MiB;
constexpr size_t WS_AUXG = 122 * MiB;
constexpr size_t WS_UPG = 280 * MiB;
constexpr size_t WS_END = 512 * MiB;
static_assert(WS_K + (size_t)(NPB * NH * TP + NSB * NH * TKS) * HD * 2 <= WS_END, "ws map");
static_assert(WS_UPG + (size_t)MTOK * DFF * 2 <= WS_END && WS_AUXA + (size_t)(MTOK / 64) * 4 * DFF * 4 <= WS_AUXG && WS_AUXG + (size_t)(MTOK / 64) * 2 * DFF * 4 <= WS_UPG, "ws map");
static_assert(WS_PROJ + (size_t)MTOK * 768 * 4 <= WS_U && WS_Q + (size_t)MTOK * 768 * 2 <= WS_U && WS_U + (size_t)MTOK * 512 * 4 <= WS_A3 && WS_A3 + (size_t)MKV * 256 * 2 <= WS_CQN && WS_CQN + (size_t)MTOK * 384 * 2 <= WS_K, "ws map");
static_assert(WS_V + (size_t)(NPB * NH * TP + NSB * NH * TKS) * VD * 2 <= WS_MIX && WS_MIX + (size_t)MTOK * 1024 * 2 <= WS_PROJ, "ws map");

constexpr int RING_BYTES = 131072;
constexpr int LDS_BYTES = 147456;

#define LDS_WAIT() asm volatile("s_waitcnt lgkmcnt(0)" ::: "memory")
__device__ __forceinline__ unsigned f2bf(float f) { unsigned u = __builtin_bit_cast(unsigned, f); return (u + 0x7fffu + ((u >> 16) & 1u)) >> 16; }
__device__ __forceinline__ unsigned pk2(float lo, float hi) { f32x2_t v = {lo, hi}; bf16x2_t b = __builtin_convertvector(v, bf16x2_t); return __builtin_bit_cast(unsigned, b); }
__device__ __forceinline__ float bflo(unsigned w) { return __uint_as_float(w << 16); }
__device__ __forceinline__ float bfhi(unsigned w) { return __uint_as_float(w & 0xffff0000u); }
__device__ __forceinline__ float wave_sum(float v) {
#pragma unroll
    for (int o = 1; o < 64; o <<= 1) v += __shfl_xor(v, o);
    return v;
}
__device__ __forceinline__ float sigmoidf_(float x) { return __builtin_amdgcn_rcpf(1.f + __expf(-x)); }

__device__ __forceinline__ int win_row(int n) {
    if (n < 672) return n;
    if (n < 1184) { const int ch = n - 672; return 768 + (ch >> 2) * 8 + (ch & 3); }
    const int ch = n - 1184; return 768 + (ch >> 2) * 8 + 4 + (ch & 3);
}
__device__ __forceinline__ int wup_row(int n) {
    if (n < 2816) return 256 * (n >> 7) + 8 * ((n & 127) >> 2) + (n & 3);
    const int ch = n - 2816; return 256 * (ch >> 7) + 8 * ((ch & 127) >> 2) + 4 + (ch & 3);
}
__device__ __forceinline__ int wukv_row(int n) {
    const int h = n >> 7, isv = (n >> 6) & 1, d = n & 63;
    return 256 * (h >> 1) + 128 * (d >> 5) + 32 * (2 * (h & 1) + isv) + (d & 31);
}
template <int RMAP>
__device__ __forceinline__ void p0_transpose_item(const float* W, int K, int N, bf16* WT, LAS float* scr, int item, int lane) {
    const int nblk = N / 32, kb = item / nblk, nb = item % nblk, k0 = 64 * kb, n0 = 32 * nb;
#pragma unroll 8
    for (int i = 0; i < 32; ++i) { const int kk = 2 * i + (lane >> 5); scr[kk * 33 + (lane & 31)] = __builtin_nontemporal_load(W + (size_t)(k0 + kk) * N + n0 + (lane & 31)); }
    LDS_WAIT(); asm volatile("" ::: "memory");
    const int c = lane & 7;
#pragma unroll
    for (int j = 0; j < 4; ++j) { const int n = (lane >> 3) + 8 * j; const LAS float* s = scr + (8 * c) * 33 + n;
        v4u o; o.x = pk2(s[0 * 33], s[1 * 33]); o.y = pk2(s[2 * 33], s[3 * 33]); o.z = pk2(s[4 * 33], s[5 * 33]); o.w = pk2(s[6 * 33], s[7 * 33]);
        const int drow = (RMAP == 1) ? win_row(n0 + n) : (RMAP == 2) ? wup_row(n0 + n) : (RMAP == 3) ? wukv_row(n0 + n) : (n0 + n);
        *(v4u*)(WT + (size_t)drow * K + k0 + 8 * c) = o; }
    LDS_WAIT(); asm volatile("" ::: "memory");
}
__device__ __forceinline__ void rms_row_to_bf16(const float* xrow, const float* g, bf16* orow, int lane) {
    const f32x4* xr = (const f32x4*)xrow + lane; const f32x4* gr = (const f32x4*)g + lane;
    f32x4 v[4]; float s = 0.f;
#pragma unroll
    for (int j = 0; j < 4; ++j) { v[j] = xr[64 * j]; s += (v[j].x * v[j].x + v[j].y * v[j].y) + (v[j].z * v[j].z + v[j].w * v[j].w); }
    const float rstd = 1.f / sqrtf(wave_sum(s) * (1.f / 1024.f) + EPS);
    v2u* o8 = (v2u*)orow + lane;
#pragma unroll
    for (int j = 0; j < 4; ++j) { const f32x4 gg = gr[64 * j]; v2u o; o.x = pk2(v[j].x * rstd * gg.x, v[j].y * rstd * gg.y); o.y = pk2(v[j].z * rstd * gg.z, v[j].w * rstd * gg.w); o8[64 * j] = o; }
}
template <int NR, class RowPtr, bool NT = false>
__device__ __forceinline__ void rms_rows_to_bf16(const RowPtr& rowptr, int m0, int stride, int mlim, const float* g, bf16* O, int lane) {
    f32x4 v[NR][4]; float ss[NR];
#pragma unroll
    for (int r = 0; r < NR; ++r) { const int m = m0 + r * stride; const float* x = rowptr(m < mlim ? m : m0);
#pragma unroll
        for (int j = 0; j < 2; ++j) {
            if (NT) { v[r][2 * j] = __builtin_nontemporal_load((const f32x4*)(x + 512 * j + 8 * lane)); v[r][2 * j + 1] = __builtin_nontemporal_load((const f32x4*)(x + 512 * j + 8 * lane + 4)); }
            else { v[r][2 * j] = *(const f32x4*)(x + 512 * j + 8 * lane); v[r][2 * j + 1] = *(const f32x4*)(x + 512 * j + 8 * lane + 4); } } }
#pragma unroll
    for (int r = 0; r < NR; ++r) { float s = 0.f;
#pragma unroll
        for (int j = 0; j < 4; ++j) s += (v[r][j].x * v[r][j].x + v[r][j].y * v[r][j].y) + (v[r][j].z * v[r][j].z + v[r][j].w * v[r][j].w);
        ss[r] = s; }
#pragma unroll
    for (int o = 1; o < 64; o <<= 1) {
#pragma unroll
        for (int r = 0; r < NR; ++r) ss[r] += __shfl_xor(ss[r], o); }
#pragma unroll
    for (int r = 0; r < NR; ++r) { const int m = m0 + r * stride; if (m < mlim) { const float rstd = 1.f / sqrtf(ss[r] * (1.f / 1024.f) + EPS);
#pragma unroll
        for (int j = 0; j < 2; ++j) { const f32x4 g0 = *(const f32x4*)(g + 512 * j + 8 * lane), g1 = *(const f32x4*)(g + 512 * j + 8 * lane + 4);
            const f32x4 a0 = v[r][2 * j] * rstd * g0, a1 = v[r][2 * j + 1] * rstd * g1; v4u a;
            a.x = pk2(a0.x, a0.y); a.y = pk2(a0.z, a0.w); a.z = pk2(a1.x, a1.y); a.w = pk2(a1.z, a1.w); *(v4u*)(O + (size_t)m * 1024 + 512 * j + 8 * lane) = a; } } }
}
__device__ __forceinline__ void sincos_acc(float ang, float& sn, float& cs) {
    const double x = (double)ang;
    const double n = __builtin_rint(x * 0.63661977236758134308);
    double r = x - n * 1.57079632679489655800e+00; r -= n * 6.12323399573676603587e-17;
    const double r2 = r * r;
    double sp = -7.6471637318198164759e-13; sp = sp * r2 + 1.6059043836821614599e-10; sp = sp * r2 - 2.5052108385441718775e-08; sp = sp * r2 + 2.7557319223985890653e-06;
    sp = sp * r2 - 1.9841269841269841270e-04; sp = sp * r2 + 8.3333333333333333333e-03; sp = sp * r2 - 1.6666666666666666667e-01; const double s = r + r * r2 * sp;
    double cp = 4.7794773323873852974e-14; cp = cp * r2 - 1.1470745597729724714e-11; cp = cp * r2 + 2.0876756987868098979e-09; cp = cp * r2 - 2.7557319223985890653e-07;
    cp = cp * r2 + 2.4801587301587301587e-05; cp = cp * r2 - 1.3888888888888888889e-03; cp = cp * r2 + 4.1666666666666666667e-02; cp = cp * r2 - 0.5; const double c = 1.0 + r2 * cp;
    const int q = ((int)n) & 3;
    const double ss = (q == 0) ? s : (q == 1) ? c : (q == 2) ? -s : -c;
    const double cc = (q == 0) ? c : (q == 1) ? -s : (q == 2) ? -c : s;
    sn = (float)ss; cs = (float)cc;
}

namespace att {
constexpr int KSLOT = 12288, VSLOT = 8192;
constexpr int LDS_K = 0, LDS_V = 2 * KSLOT, LDS_WS = LDS_V + 2 * VSLOT, LDS_END = LDS_WS + NWAVES * 32 * 4;
__device__ __forceinline__ int crow(int r, int hi) { return (r & 3) + 8 * (r >> 2) + 4 * hi; }
__device__ __forceinline__ void glds16(const void* gsrc, unsigned lds_dst) { unsigned keep;
    asm volatile("s_mov_b32 %0, m0\n\ts_mov_b32 m0, %2\n\ts_nop 0\n\tglobal_load_lds_dwordx4 %1, off\n\ts_mov_b32 m0, %0" : "=&s"(keep) : "v"(gsrc), "s"(lds_dst) : "memory"); }
typedef short v4i16_t __attribute__((ext_vector_type(4)));
__device__ __forceinline__ s16x4 vtr(const LAS char* p) { return __builtin_bit_cast(s16x4, __builtin_amdgcn_ds_read_tr16_b64_v4i16((LAS v4i16_t*)p)); }
#define MFMA32(a, b, c) __builtin_amdgcn_mfma_f32_32x32x16_bf16((a), (b), (c), 0, 0, 0)

__device__ __forceinline__ void attn_unit(LAS unsigned char* lds, const bf16* Qrows, const bf16* Kb, const bf16* Vb, bf16* Orows, int pos0, int nrows,
                                          const float* gq, const float* ropec, const float* ropes) {
    int tid = threadIdx.x; asm volatile("" : "+v"(tid)); const int lane = tid & 63, r32 = lane & 31, hi = lane >> 5; const int wid = __builtin_amdgcn_readfirstlane(tid >> 6);
    const unsigned lds0 = (unsigned)(uintptr_t)lds;
    const bool active = (wid * 32 < nrows);
    const int NT = (pos0 + nrows - 1) / 64 + 1;
    const int ntw = active ? (pos0 + wid * 32) / 64 + 1 : 0;
    LAS float* wsf = (LAS float*)(lds + LDS_WS) + wid * 32;
    const bf16* ksrc = Kb + (size_t)lane * HD + wid * 8;
    const bf16* vsrc = Vb + (size_t)(16 * (wid & 3) + (lane >> 2)) * VD + (wid >> 2) * 32 + (lane & 3) * 8;
#define ATT_DMA_K(t, slot) do { glds16(ksrc + (size_t)(t) * 64 * HD, (unsigned)__builtin_amdgcn_readfirstlane(lds0 + LDS_K + (slot) * KSLOT + wid * 1024)); \
        if (wid < 4) glds16(ksrc + (size_t)(t) * 64 * HD + 64, (unsigned)__builtin_amdgcn_readfirstlane(lds0 + LDS_K + (slot) * KSLOT + (8 + wid) * 1024)); } while (0)
#define ATT_DMA_V(t, slot) glds16(vsrc + (size_t)(t) * 64 * VD, (unsigned)__builtin_amdgcn_readfirstlane(lds0 + LDS_V + (slot) * VSLOT + wid * 1024))
    ATT_DMA_K(0, 0); if (NT > 1) ATT_DMA_K(1, 1); ATT_DMA_V(0, 0);
    bf16x8 qr[6];
#pragma unroll
    for (int d0 = 0; d0 < 6; ++d0) qr[d0] = (bf16x8){0, 0, 0, 0, 0, 0, 0, 0};
    if (active) {
        const bf16* qp = Qrows + (size_t)(32 * wid + r32) * 768 + 8 * hi;
        float qv[6][8]; float ss = 0.f;
#pragma unroll
        for (int d0 = 0; d0 < 6; ++d0) { const v4u raw = *(const v4u*)(qp + 16 * d0);
#pragma unroll
            for (int j = 0; j < 4; ++j) { qv[d0][2 * j] = bflo(raw[j]); qv[d0][2 * j + 1] = bfhi(raw[j]); }
#pragma unroll
            for (int j = 0; j < 8; ++j) ss += qv[d0][j] * qv[d0][j]; }
        ss += __shfl_xor(ss, 32);
        const float rstd = 1.f / sqrtf(ss * (1.f / 96.f) + EPS);
#pragma unroll
        for (int d0 = 0; d0 < 6; ++d0)
#pragma unroll
            for (int j = 0; j < 8; ++j) qv[d0][j] *= rstd * gq[16 * d0 + 8 * hi + j];
        const int pos = pos0 + 32 * wid + r32;
        const float* cs = ropec + (size_t)pos * 16 + 8 * hi; const float* sn = ropes + (size_t)pos * 16 + 8 * hi;
#pragma unroll
        for (int j = 0; j < 8; ++j) { const float c = cs[j], s = sn[j], p1 = qv[4][j], p2 = qv[5][j]; qv[4][j] = p1 * c - p2 * s; qv[5][j] = p2 * c + p1 * s; }
        const float qs = 0.10206207261596575f * 1.4426950408889634f;
#pragma unroll
        for (int d0 = 0; d0 < 6; ++d0) { v4u w;
#pragma unroll
            for (int j = 0; j < 4; ++j) w[j] = pk2(qv[d0][2 * j] * qs, qv[d0][2 * j + 1] * qs);
            qr[d0] = __builtin_bit_cast(bf16x8, w); }
    }
    constexpr float THR = 24.f;
    float m_run = 0.f, l_run = 0.f;
    f32x16 o[2], negm;
#pragma unroll
    for (int r = 0; r < 16; ++r) { o[0][r] = 0.f; o[1][r] = 0.f; negm[r] = 0.f; }
    const LAS char* kp0 = (const LAS char*)lds + LDS_K + hi * 1024 + r32 * 16;
    const LAS char* vp0 = (const LAS char*)lds + LDS_V + ((lane >> 4) & 1) * 32 + (lane & 3) * 8 + (4 * hi + ((lane & 15) >> 2)) * 64;
#define SBAR() __builtin_amdgcn_sched_barrier(0)
#define MX3(a, b, c) __builtin_fmaxf(__builtin_fmaxf((a), (b)), (c))
#define QK_STEP(N0, N1, KP, d0, CIN0, CIN1) do { const bf16x8 k0_ = *(const LAS bf16x8*)((KP) + (d0) * 2048), k1_ = *(const LAS bf16x8*)((KP) + (d0) * 2048 + 512); \
        N0 = MFMA32(k0_, qr[d0], CIN0); N1 = MFMA32(k1_, qr[d0], CIN1); } while (0)
#define TILE_MAX(M, C0, C1) do { float a_ = MX3(C0[0], C0[1], C1[0]), b_ = MX3(C0[2], C0[3], C1[1]); a_ = MX3(a_, C1[2], C1[3]); \
        _Pragma("unroll") for (int r = 4; r < 16; r += 4) { a_ = MX3(a_, C0[r], C0[r + 1]); b_ = MX3(b_, C0[r + 2], C0[r + 3]); a_ = MX3(a_, C1[r], C1[r + 1]); b_ = MX3(b_, C1[r + 2], C1[r + 3]); } \
        M = __builtin_fmaxf(a_, b_); } while (0)
#define SM_EXP8(C, B) do { _Pragma("unroll") for (int r = (B); r < (B) + 8; ++r) { C[r] = __builtin_amdgcn_exp2f(C[r]); rs += C[r]; } } while (0)
#define SM_PACK() do { v4u w_; \
        w_.x = pk2(c0[0], c0[1]); w_.y = pk2(c0[2], c0[3]); w_.z = pk2(c0[4], c0[5]); w_.w = pk2(c0[6], c0[7]); pa[0] = __builtin_bit_cast(bf16x8, w_); \
        w_.x = pk2(c0[8], c0[9]); w_.y = pk2(c0[10], c0[11]); w_.z = pk2(c0[12], c0[13]); w_.w = pk2(c0[14], c0[15]); pa[1] = __builtin_bit_cast(bf16x8, w_); \
        w_.x = pk2(c1[0], c1[1]); w_.y = pk2(c1[2], c1[3]); w_.z = pk2(c1[4], c1[5]); w_.w = pk2(c1[6], c1[7]); pa[2] = __builtin_bit_cast(bf16x8, w_); \
        w_.x = pk2(c1[8], c1[9]); w_.y = pk2(c1[10], c1[11]); w_.z = pk2(c1[12], c1[13]); w_.w = pk2(c1[14], c1[15]); pa[3] = __builtin_bit_cast(bf16x8, w_); \
        l_run += rs; } while (0)
#define FIX_REF() do { if (__any(mxc > THR)) { const float mx_ = __builtin_fmaxf(mxc, __shfl_xor(mxc, 32)); const float dl_ = __builtin_fmaxf(mx_, 0.f); \
        m_run += dl_; _Pragma("unroll") for (int r = 0; r < 16; ++r) { c0[r] -= dl_; c1[r] -= dl_; negm[r] = -m_run; } \
        const float f_ = __builtin_amdgcn_exp2f(-dl_); l_run *= f_; if (hi == 0) wsf[r32] = f_; LDS_WAIT(); \
        _Pragma("unroll") for (int r = 0; r < 16; ++r) { const float a_ = wsf[crow(r, hi)]; o[0][r] *= a_; o[1][r] *= a_; } LDS_WAIT(); } } while (0)
#define PV_TILE(VP) do { _Pragma("unroll") for (int s_ = 0; s_ < 4; ++s_) _Pragma("unroll") for (int dh = 0; dh < 2; ++dh) { \
        const s16x4 lo_ = vtr((VP) + dh * 4096 + s_ * 1024), h4_ = vtr((VP) + dh * 4096 + s_ * 1024 + 512); \
        const bf16x8 vf_ = (bf16x8){lo_[0], lo_[1], lo_[2], lo_[3], h4_[0], h4_[1], h4_[2], h4_[3]}; \
        o[dh] = MFMA32(pa[s_], vf_, o[dh]); } } while (0)
    asm volatile("s_waitcnt vmcnt(0)" ::: "memory");
    __builtin_amdgcn_s_barrier();
    f32x16 c0 = negm, c1 = negm; float mxc = 0.f;
    if (ntw > 0) {
#pragma unroll
        for (int d0 = 0; d0 < 6; ++d0) QK_STEP(c0, c1, kp0, d0, c0, c1);
        TILE_MAX(mxc, c0, c1);
    }
    for (int t = 0; t < NT; ++t) {
        asm volatile("s_waitcnt vmcnt(0)" ::: "memory");
        __builtin_amdgcn_s_barrier();
        if (t + 2 < NT) ATT_DMA_K(t + 2, t & 1);
        if (t + 1 < NT) ATT_DMA_V(t + 1, (t + 1) & 1);
        if (t + 1 < ntw) {
            FIX_REF();
            const LAS char* kp = kp0 + ((t + 1) & 1) * KSLOT; const LAS char* vp = vp0 + (t & 1) * VSLOT;
            f32x16 n0, n1; bf16x8 pa[4]; float rs = 0.f;
#define KLD(A0, A1, d0) do { A0 = *(const LAS bf16x8*)(kp + (d0) * 2048); A1 = *(const LAS bf16x8*)(kp + (d0) * 2048 + 512); } while (0)
#define VLD(F, s_, dh) do { const s16x4 lo_ = vtr(vp + (dh) * 4096 + (s_) * 1024), h4_ = vtr(vp + (dh) * 4096 + (s_) * 1024 + 512); \
        F = (bf16x8){lo_[0], lo_[1], lo_[2], lo_[3], h4_[0], h4_[1], h4_[2], h4_[3]}; } while (0)
            bf16x8 ka0, ka1, kb0, kb1, va0, va1, vb0, vb1;
            SBAR();
            KLD(ka0, ka1, 0); KLD(kb0, kb1, 1); SM_EXP8(c0, 0); SBAR();
            n0 = MFMA32(ka0, qr[0], negm); n1 = MFMA32(ka1, qr[0], negm); KLD(ka0, ka1, 2); SM_EXP8(c0, 8); SBAR();
            n0 = MFMA32(kb0, qr[1], n0); n1 = MFMA32(kb1, qr[1], n1); KLD(kb0, kb1, 3); SM_EXP8(c1, 0); SBAR();
            n0 = MFMA32(ka0, qr[2], n0); n1 = MFMA32(ka1, qr[2], n1); KLD(ka0, ka1, 4); SM_EXP8(c1, 8); SBAR();
            n0 = MFMA32(kb0, qr[3], n0); n1 = MFMA32(kb1, qr[3], n1); KLD(kb0, kb1, 5); SM_PACK(); SBAR();
            n0 = MFMA32(ka0, qr[4], n0); n1 = MFMA32(ka1, qr[4], n1); VLD(va0, 0, 0); VLD(va1, 0, 1); SBAR();
            n0 = MFMA32(kb0, qr[5], n0); n1 = MFMA32(kb1, qr[5], n1); VLD(vb0, 1, 0); VLD(vb1, 1, 1); SBAR();
            o[0] = MFMA32(pa[0], va0, o[0]); o[1] = MFMA32(pa[0], va1, o[1]); VLD(va0, 2, 0); VLD(va1, 2, 1); SBAR();
            o[0] = MFMA32(pa[1], vb0, o[0]); o[1] = MFMA32(pa[1], vb1, o[1]); VLD(vb0, 3, 0); VLD(vb1, 3, 1); SBAR();
            o[0] = MFMA32(pa[2], va0, o[0]); o[1] = MFMA32(pa[2], va1, o[1]); SBAR();
            o[0] = MFMA32(pa[3], vb0, o[0]); o[1] = MFMA32(pa[3], vb1, o[1]);
#undef KLD
#undef VLD
            c0 = n0; c1 = n1;
            TILE_MAX(mxc, c0, c1);
        } else if (t < ntw) {
            FIX_REF();
            const LAS char* vp = vp0 + (t & 1) * VSLOT;
            bf16x8 pa[4]; float rs = 0.f;
            SM_EXP8(c0, 0); SM_EXP8(c0, 8); SM_EXP8(c1, 0); SM_EXP8(c1, 8); SM_PACK();
            PV_TILE(vp);
        }
    }
#undef SBAR
#undef MX3
#undef QK_STEP
#undef TILE_MAX
#undef SM_EXP8
#undef SM_PACK
#undef FIX_REF
#undef PV_TILE
    if (active) {
        l_run += __shfl_xor(l_run, 32);
        if (hi == 0) wsf[r32] = l_run;
        LDS_WAIT();
        int r32b = r32, hib = hi; asm volatile("" : "+v"(r32b), "+v"(hib));
        bf16* op = Orows + (size_t)(32 * wid + 4 * hib) * 1024 + r32b;
        const LAS float* lw = wsf + 4 * hib;
#pragma unroll
        for (int r = 0; r < 16; ++r) { const int q = (r & 3) + 8 * (r >> 2); const float inv = __builtin_amdgcn_rcpf(lw[q]);
            op[(size_t)q * 1024] = (bf16)f2bf(o[0][r] * inv); op[(size_t)q * 1024 + 32] = (bf16)f2bf(o[1][r] * inv); }
    }
    asm volatile("s_waitcnt lgkmcnt(0)" ::: "memory");
    __builtin_amdgcn_s_barrier();
#undef ATT_DMA_K
#undef ATT_DMA_V
}
}

#define XB_TMO      128
#define XB_XCNT(j)  (256  + 64 * (j))
#define XB_XSUB(j)  (1280 + 64 * (j))
#define XB_XGEN(j)  (2304 + 64 * (j))
#define XB_TOP      3328
#define XB_TOPGEN   3392
#define XCD_BAR_WORDS 3456
#define XB_SPIN_CAP (1u << 18)

__device__ __forceinline__ unsigned xb_ld(unsigned* p)              { return __hip_atomic_load(p, __ATOMIC_RELAXED, __HIP_MEMORY_SCOPE_AGENT); }
__device__ __forceinline__ unsigned xb_add(unsigned* p, unsigned v) { return __hip_atomic_fetch_add(p, v, __ATOMIC_RELAXED, __HIP_MEMORY_SCOPE_AGENT); }
__device__ __forceinline__ unsigned xb_xcc_id() { return (unsigned)__builtin_amdgcn_s_getreg((3 << 11) | 20) & 0xFu; }
#define XB_SPIN(cond, bar) do { unsigned _sp = 0; while (cond) { __builtin_amdgcn_s_sleep(1); \
    if ((++_sp & 255u) == 0u) { if (xb_ld(&(bar)[XB_TMO])) break; if (_sp > XB_SPIN_CAP) { atomicAdd(&(bar)[XB_TMO], 1u); break; } } } } while (0)

struct XcdBarrier {
    unsigned* bar; unsigned x;
    volatile LAS unsigned* st;
};

__device__ __forceinline__ XcdBarrier xcd_barrier_post(unsigned* bar, volatile LAS unsigned* st) {
    XcdBarrier b; b.bar = bar; b.x = xb_xcc_id(); b.st = st;
    if (threadIdx.x == 0) (void)xb_add(&bar[XB_XCNT(b.x)], 1u);
    return b;
}
__device__ __forceinline__ void xcd_barrier_complete(unsigned* bar, unsigned x, unsigned& nloc, unsigned& nx) {
    const unsigned G = gridDim.x * gridDim.y * gridDim.z;
    unsigned sum, cnt, mine, sp = 0u;
    for (;;) {
        sum = 0u; cnt = 0u; mine = 0u;
#pragma unroll
        for (unsigned j = 0; j < 16; ++j) { const unsigned c = xb_ld(&bar[XB_XCNT(j)]); sum += c; cnt += (c > 0u) ? 1u : 0u; mine = (j == x) ? c : mine; }
        if (sum == G) break;
        __builtin_amdgcn_s_sleep(1);
        if ((++sp & 255u) == 0u) { if (xb_ld(&bar[XB_TMO])) break; if (sp > XB_SPIN_CAP) { atomicAdd(&bar[XB_TMO], 1u); break; } }
    }
    nloc = mine > 0u ? mine : 1u; nx = cnt > 0u ? cnt : 1u;
}

__device__ __forceinline__ void xcd_barrier(const XcdBarrier& b) {
    asm volatile("s_waitcnt vmcnt(0)" ::: "memory");
    __syncthreads();
    if (threadIdx.x == 0) {
        unsigned* bar = b.bar;
        __builtin_amdgcn_s_waitcnt(0);
        unsigned nloc = b.st[0], nx = b.st[1];
        if (nloc == 0u) { xcd_barrier_complete(bar, b.x, nloc, nx); b.st[0] = nloc; b.st[1] = nx; }
        const unsigned old = xb_add(&bar[XB_XSUB(b.x)], 1u);
        const unsigned gen = old / nloc;
        if (old + 1u == (gen + 1u) * nloc) {
            __builtin_amdgcn_fence(__ATOMIC_RELEASE, "agent");
            asm volatile("s_waitcnt vmcnt(0)" ::: "memory");
            const unsigned og = xb_add(&bar[XB_TOP], 1u);
            const unsigned tg = og / nx;
            if (og + 1u == (tg + 1u) * nx) xb_add(&bar[XB_TOPGEN], 1u);
            else XB_SPIN(xb_ld(&bar[XB_TOPGEN]) == tg, bar);
            __builtin_amdgcn_fence(__ATOMIC_ACQUIRE, "agent");
            xb_add(&bar[XB_XGEN(b.x)], 1u);
            asm volatile("s_waitcnt vmcnt(0)" ::: "memory");
        } else {
            XB_SPIN(xb_ld(&bar[XB_XGEN(b.x)]) == gen, bar);
            __builtin_amdgcn_fence(__ATOMIC_ACQUIRE, "agent");
            asm volatile("s_waitcnt vmcnt(0)" ::: "memory");
        }
    }
    __syncthreads();
}

struct Args { const float* in[23]; float* out; unsigned char* ws; };
enum { I_XP = 0, I_XS, I_CKV, I_KPE, I_SCONV, I_SFFN, I_ATTN_NORM, I_WIN, I_QNORM, I_WUQ, I_KVNORM, I_WUKV, I_QKNQ, I_QKNK, I_CONVW, I_CONVB, I_CONVN, I_WOUT, I_FFNN, I_WUP, I_FCW, I_FCB, I_WDOWN };

__global__ void __launch_bounds__(NWAVES * 64, 2) mk_fwd(Args args) {
    extern __shared__ __attribute__((aligned(16))) unsigned char lds_raw[];
    LAS unsigned char* lds = (LAS unsigned char*)lds_raw;
    const int G = gridDim.x, bx = blockIdx.x;
    const int vcu = (G % 8 == 0) ? (bx % 8) * (G / 8) + bx / 8 : bx;
    const int NGW = G * NWAVES; const size_t NGT = (size_t)G * NWAVES * 64;
#define PHASE_IDS() int tid = threadIdx.x; asm volatile("" : "+v"(tid)); const int lane = tid & 63, wave = __builtin_amdgcn_readfirstlane(tid >> 6); \
    const int gw = vcu * NWAVES + wave; const size_t gtid = (size_t)bx * (NWAVES * 64) + tid; (void)lane; (void)gw; (void)gtid
    unsigned char* ws = args.ws; float* out = args.out;
    volatile LAS unsigned* bar_st = (volatile LAS unsigned*)(lds + RING_BYTES + 512);
    if (threadIdx.x < 4) bar_st[threadIdx.x] = 0u;
    __syncthreads();
    const XcdBarrier xbar = xcd_barrier_post((unsigned*)(ws + WS_CTL) + CW_BAR, bar_st);
#define GRID_BAR() xcd_barrier(xbar)
    const float* xp = args.in[I_XP]; const float* xs = args.in[I_XS];
    bf16* Win_t = (bf16*)(ws + WS_WIN); bf16* Wuq_t = (bf16*)(ws + WS_WUQ); bf16* Wukv_t = (bf16*)(ws + WS_WUKV); bf16* Wout_t = (bf16*)(ws + WS_WOUT);
    bf16* Wup_t = (bf16*)(ws + WS_WUP); bf16* Wdown_t = (bf16*)(ws + WS_WDOWN);
    float* ropec = (float*)(ws + WS_ROPEC); float* ropes = (float*)(ws + WS_ROPES);
    bf16* XN = (bf16*)(ws + WS_XN); bf16* Vbuf = (bf16*)(ws + WS_V); bf16* MIX = (bf16*)(ws + WS_MIX); float* PROJ = (float*)(ws + WS_PROJ);
    bf16* A3 = (bf16*)(ws + WS_A3); bf16* CQN = (bf16*)(ws + WS_CQN); bf16* Qb = (bf16*)(ws + WS_Q);
    float* U = (float*)(ws + WS_U); bf16* Kbuf = (bf16*)(ws + WS_K); float* AUXA = (float*)(ws + WS_AUXA); float* AUXG = (float*)(ws + WS_AUXG); bf16* UPG = (bf16*)(ws + WS_UPG);

    {
        PHASE_IDS();
        LAS float* scr = (LAS float*)(lds + wave * 16384);
        constexpr int I_IN = (1024 / 64) * (1696 / 32), I_UQ = (384 / 64) * (768 / 32), I_UKV = (256 / 64) * (1024 / 32), I_OUT = (1024 / 64) * (1024 / 32),
                      I_UP = (1024 / 64) * (5632 / 32), I_DOWN = (2816 / 64) * (1024 / 32);
        constexpr int NITEMS = I_IN + I_UQ + I_UKV + I_OUT + I_UP + I_DOWN;
        for (int it = gw; it < NITEMS; it += NGW) {
            int r = it;
            if (r < I_IN) { p0_transpose_item<1>(args.in[I_WIN], 1024, 1696, Win_t, scr, r, lane); continue; } r -= I_IN;
            if (r < I_UQ) { p0_transpose_item<0>(args.in[I_WUQ], 384, 768, Wuq_t, scr, r, lane); continue; } r -= I_UQ;
            if (r < I_UKV) { p0_transpose_item<3>(args.in[I_WUKV], 256, 1024, Wukv_t, scr, r, lane); continue; } r -= I_UKV;
            if (r < I_OUT) { p0_transpose_item<0>(args.in[I_WOUT], 1024, 1024, Wout_t, scr, r, lane); continue; } r -= I_OUT;
            if (r < I_UP) { p0_transpose_item<2>(args.in[I_WUP], 1024, 5632, Wup_t, scr, r, lane); continue; } r -= I_UP;
            p0_transpose_item<0>(args.in[I_WDOWN], 2816, 1024, Wdown_t, scr, r, lane);
        }
        for (size_t i = gtid; i < (size_t)96 * 1024 / 8; i += NGT) ((v4u*)(Win_t + (size_t)672 * 1024))[i] = (v4u){0u, 0u, 0u, 0u};
        { auto xrow = [=](int m) { return m < MP ? xp + (size_t)m * DM : xs + (size_t)(m - MP) * DM; };
          for (int m = gw; m < MTOK; m += 4 * NGW) rms_rows_to_bf16<4, decltype(xrow), true>(xrow, m, NGW, MTOK, args.in[I_ATTN_NORM], XN, lane); }
        { const float* c = args.in[I_CKV]; bf16* dst = A3 + (size_t)MTOK * KVLORA;
          for (size_t i = gtid; i < (size_t)NSB * PAST * KVLORA / 8; i += NGT) { const f32x4 a = __builtin_nontemporal_load((const f32x4*)c + 2 * i), b = __builtin_nontemporal_load((const f32x4*)c + 2 * i + 1);
              v4u o; o.x = pk2(a.x, a.y); o.y = pk2(a.z, a.w); o.z = pk2(b.x, b.y); o.w = pk2(b.z, b.w); ((v4u*)dst)[i] = o; } }
        for (size_t i = gtid; i < (size_t)TP * 16; i += NGT) { const int pos = (int)(i >> 4), k = (int)(i & 15);
            double inv = 1.0; for (int j = 0; j < k; ++j) inv *= 0.56234132519034908039;
            const float ang = (float)pos * (float)inv; float sn, cs; sincos_acc(ang, sn, cs); ropec[i] = cs; ropes[i] = sn; }
    }
    GRID_BAR();

    {
        pg8::Gemm g{XN, Win_t, MTOK, NIN_PAD, 1024}; pg8::StaticOrder S; S.init(MTOK, NIN_PAD, G, bx);
        pg8::EpiInProj E{PROJ, U};
        pg8::gemm_phase<pg8::EpiInProj, pg8::StaticOrder, true, true>(lds, g, S, E);
    }
    GRID_BAR();

    {
        PHASE_IDS();
        const float* qn = args.in[I_QNORM]; const float* kvn = args.in[I_KVNORM];
        const f32x4 z4 = {0.f, 0.f, 0.f, 0.f};
        const bool lq = lane < 48, lk = lane < 32, lp = lane < 8;
        const f32x4 gq0 = lq ? *(const f32x4*)(qn + 8 * lane) : z4, gq1 = lq ? *(const f32x4*)(qn + 8 * lane + 4) : z4;
        const f32x4 gk0 = lk ? *(const f32x4*)(kvn + 8 * lane) : z4, gk1 = lk ? *(const f32x4*)(kvn + 8 * lane + 4) : z4;
        constexpr int P2R = 4;
        for (int mA = gw; mA < MTOK; mA += P2R * NGW) {
            f32x4 q0[P2R], q1[P2R], k0[P2R], k1[P2R], pe[P2R];
#pragma unroll
            for (int rr = 0; rr < P2R; ++rr) { const int mr = mA + rr * NGW; const float* pr = PROJ + (size_t)(mr < MTOK ? mr : mA) * 768;
                q0[rr] = lq ? *(const f32x4*)(pr + 8 * lane) : z4; q1[rr] = lq ? *(const f32x4*)(pr + 8 * lane + 4) : z4;
                k0[rr] = lk ? *(const f32x4*)(pr + 384 + 8 * lane) : z4; k1[rr] = lk ? *(const f32x4*)(pr + 384 + 8 * lane + 4) : z4;
                pe[rr] = lp ? *(const f32x4*)(pr + 640 + 4 * lane) : z4; }
#pragma unroll
            for (int rr = 0; rr < P2R; ++rr) {
                const int m = (mA + rr * NGW < MTOK) ? mA + rr * NGW : mA;
                const f32x4 a0 = q0[rr], a1 = q1[rr], b0 = k0[rr], b1 = k1[rr];
                const float s = (a0.x * a0.x + a0.y * a0.y) + (a0.z * a0.z + a0.w * a0.w) + (a1.x * a1.x + a1.y * a1.y) + (a1.z * a1.z + a1.w * a1.w);
                const float s2 = (b0.x * b0.x + b0.y * b0.y) + (b0.z * b0.z + b0.w * b0.w) + (b1.x * b1.x + b1.y * b1.y) + (b1.z * b1.z + b1.w * b1.w);
                const float rq = 1.f / sqrtf(wave_sum(s) * (1.f / 384.f) + EPS), rk = 1.f / sqrtf(wave_sum(s2) * (1.f / 256.f) + EPS);
                if (lq) { const f32x4 y0 = a0 * rq * gq0, y1 = a1 * rq * gq1; v4u o; o.x = pk2(y0.x, y0.y); o.y = pk2(y0.z, y0.w); o.z = pk2(y1.x, y1.y); o.w = pk2(y1.z, y1.w);
                    *(v4u*)(CQN + (size_t)m * QLORA + 8 * lane) = o; }
                if (lk) { const f32x4 y0 = b0 * rk * gk0, y1 = b1 * rk * gk1;
                    float* ock = (m < MP) ? out + O_CKVP + (size_t)m * KVLORA : out + O_CKVS + (size_t)(m - MP) * KVLORA;
                    *(f32x4*)(ock + 8 * lane) = y0; *(f32x4*)(ock + 8 * lane + 4) = y1;
                    v4u o; o.x = pk2(y0.x, y0.y); o.y = pk2(y0.z, y0.w); o.z = pk2(y1.x, y1.y); o.w = pk2(y1.z, y1.w);
                    *(v4u*)(A3 + (size_t)m * KVLORA + 8 * lane) = o; }
                if (lp) { float* okp = (m < MP) ? out + O_KPEP + (size_t)m * ROPE : out + O_KPES + (size_t)(m - MP) * ROPE; *(f32x4*)(okp + 4 * lane) = pe[rr]; }
            }
        }
        for (int r = gw; r < (NPB + NSB) * 30; r += NGW) {
            const int sq = r / 30, i = r % 30;
            const float* src; float* dst;
            if (sq < NPB) { src = U + (size_t)(sq * TP + TP - 30 + i) * CONVCH; dst = out + O_CONVP + (size_t)(sq * 30 + i) * CONVCH; }
            else { const int b = sq - NPB; src = U + (size_t)(MP + b * TS + TS - 30 + i) * CONVCH; dst = out + O_CONVS + (size_t)(b * 30 + i) * CONVCH; }
#pragma unroll
            for (int j = 0; j < 2; ++j) ((f32x4*)dst)[64 * j + lane] = ((const f32x4*)src)[64 * j + lane];
        }
    }
    GRID_BAR();

    {
        { pg8::Gemm g{CQN, Wuq_t, MTOK, 768, 384}; pg8::StaticOrder S; S.init(MTOK, 768, G, (G == 256) ? (bx + 240) % 256 : bx);
          pg8::EpiBf16 E{Qb, 768, 0, 0};
          pg8::gemm_phase<pg8::EpiBf16, pg8::StaticOrder, true, true>(lds, g, S, E); }
        { pg8::Gemm g{A3, Wukv_t, MKV, 1024, 256}; pg8::StaticOrder S; S.init(MKV, 1024, G, bx);
          pg8::EpiKV E{Kbuf, Vbuf, out + O_KPEP, out + O_KPES, args.in[I_KPE], args.in[I_QKNK], ropec, ropes};
          pg8::gemm_phase<pg8::EpiKV, pg8::StaticOrder, true, true>(lds, g, S, E); }
    }
    GRID_BAR();

    {
        const float* gq = args.in[I_QKNQ];
        if (G == 256) {
            const int bh = vcu >> 4, s = vcu & 15;
            const int b = bh >> 3, h = bh & 7;
            for (int i = 0; i < 4; ++i) {
                const int qb = (i == 0) ? 63 - s : (i == 1) ? 32 + s : (i == 2) ? 31 - s : s;
                const size_t row0 = (size_t)b * TP + (size_t)qb * 256;
                att::attn_unit(lds, Qb + row0 * 768 + h * HD, Kbuf + (size_t)bh * TP * HD, Vbuf + (size_t)bh * TP * VD, MIX + row0 * 1024 + h * VD, qb * 256, 256, gq, ropec, ropes);
            }
            if (vcu < NSB * NH) {
                const int sb = vcu >> 3, sh = vcu & 7;
                const size_t row0 = (size_t)MP + (size_t)sb * TS;
                att::attn_unit(lds, Qb + row0 * 768 + sh * HD, Kbuf + ((size_t)NPB * NH * TP + (size_t)vcu * TKS) * HD, Vbuf + ((size_t)NPB * NH * TP + (size_t)vcu * TKS) * VD,
                               MIX + row0 * 1024 + sh * VD, PAST, TS, gq, ropec, ropes);
            }
        } else {
            for (int u = vcu; u < NPB * NH * 64 + NSB * NH; u += G) {
                if (u < NPB * NH * 64) { const int bh = u >> 6, qb = u & 63, b = bh >> 3, h = bh & 7; const size_t row0 = (size_t)b * TP + (size_t)qb * 256;
                    att::attn_unit(lds, Qb + row0 * 768 + h * HD, Kbuf + (size_t)bh * TP * HD, Vbuf + (size_t)bh * TP * VD, MIX + row0 * 1024 + h * VD, qb * 256, 256, gq, ropec, ropes); }
                else { const int v = u - NPB * NH * 64; const int sb = v >> 3, sh = v & 7; const size_t row0 = (size_t)MP + (size_t)sb * TS;
                    att::attn_unit(lds, Qb + row0 * 768 + sh * HD, Kbuf + ((size_t)NPB * NH * TP + (size_t)v * TKS) * HD, Vbuf + ((size_t)NPB * NH * TP + (size_t)v * TKS) * VD,
                                   MIX + row0 * 1024 + sh * VD, PAST, TS, gq, ropec, ropes); }
            }
        }
        __syncthreads();
        {
            PHASE_IDS();
            const int c = tid;
            float w[CONVK];
#pragma unroll
            for (int k = 0; k < CONVK; ++k) w[k] = args.in[I_CONVW][k * CONVCH + c];
            const float bias = args.in[I_CONVB][c], gn = args.in[I_CONVN][c];
            LAS float* red = (LAS float*)lds;
            LAS float* rsd = red + 128;
            constexpr int TB = 16, NITEM = NPB * (TP / TB) + NSB * (TS / TB);
            static_assert(NITEM == 2112, "conv item deal");
            const int nmine = (vcu >= 128 || G != 256) ? 11 : (vcu < 64 ? 6 : 5);
            for (int k = 0; k < (G == 256 ? nmine : (NITEM + G - 1) / G); ++k) {
                const int it = (G != 256) ? vcu + k * G : (vcu >= 128 ? (vcu - 128) * 11 + k : 1408 + vcu + 128 * k);
                if (it >= NITEM) break;
                const float* ubase; const float* hist; size_t mrow0; int t0;
                if (it < NPB * (TP / TB)) { const int b = it / (TP / TB); t0 = (it % (TP / TB)) * TB; mrow0 = (size_t)b * TP; hist = nullptr; }
                else { const int j = it - NPB * (TP / TB); const int b = j / (TS / TB); t0 = (j % (TS / TB)) * TB; mrow0 = (size_t)MP + (size_t)b * TS; hist = args.in[I_SCONV] + (size_t)b * 30 * CONVCH; }
                ubase = U + mrow0 * CONVCH;
                float win[TB + 30];
#pragma unroll
                for (int i = 0; i < TB + 30; ++i) { const int t = t0 - 30 + i;
                    win[i] = (t >= 0) ? ubase[(size_t)t * CONVCH + c] : (hist ? hist[(30 + t) * CONVCH + c] : 0.f); }
                float y[TB];
#pragma unroll
                for (int j = 0; j < TB; ++j) { float a = bias;
#pragma unroll
                    for (int k = 0; k < CONVK; ++k) a += w[k] * win[j + k];
                    y[j] = a; }
                float z8[8], z4[4], z2[2], z1;
                { const bool up = (lane & 32) != 0;
#pragma unroll
                  for (int j = 0; j < 8; ++j) { const float lo = y[j] * y[j], hi = y[j + 8] * y[j + 8]; const float keep = up ? hi : lo, send = up ? lo : hi; z8[j] = keep + __shfl_xor(send, 32); } }
                { const bool up = (lane & 16) != 0;
#pragma unroll
                  for (int j = 0; j < 4; ++j) { const float keep = up ? z8[j + 4] : z8[j], send = up ? z8[j] : z8[j + 4]; z4[j] = keep + __shfl_xor(send, 16); } }
                { const bool up = (lane & 8) != 0;
#pragma unroll
                  for (int j = 0; j < 2; ++j) { const float keep = up ? z4[j + 2] : z4[j], send = up ? z4[j] : z4[j + 2]; z2[j] = keep + __shfl_xor(send, 8); } }
                { const bool up = (lane & 4) != 0; const float keep = up ? z2[1] : z2[0], send = up ? z2[0] : z2[1]; z1 = keep + __shfl_xor(send, 4); }
                z1 += __shfl_xor(z1, 2); z1 += __shfl_xor(z1, 1);
                if ((lane & 3) == 0) red[wave * 16 + (lane >> 2)] = z1;
                __syncthreads();
                if (tid < 16) { float tot = 0.f;
#pragma unroll
                    for (int w8 = 0; w8 < 8; ++w8) tot += red[w8 * 16 + tid];
                    rsd[tid] = 1.f / sqrtf(tot * (1.f / 512.f) + EPS); }
                __syncthreads();
#pragma unroll
                for (int j = 0; j < TB; ++j) { const float v = y[j] * rsd[j] * gn;
                    MIX[(mrow0 + t0 + j) * 1024 + 512 + c] = (bf16)f2bf(v * __builtin_amdgcn_rcpf(1.f + __expf(-v))); }
            }
        }
    }
    GRID_BAR();

    {
        pg8::Gemm g{MIX, Wout_t, MTOK, 1024, 1024}; pg8::StaticOrder S; S.init(MTOK, 1024, G, bx);
        pg8::EpiRes<false> E{xp, xs, out};
        pg8::gemm_phase<pg8::EpiRes<false>, pg8::StaticOrder, true, true>(lds, g, S, E);
    }
    GRID_BAR();

    { PHASE_IDS(); auto orow = [=](int m) { return (const float*)out + (size_t)m * DM; };
      for (int m = gw; m < MTOK; m += 4 * NGW) rms_rows_to_bf16<4>(orow, m, NGW, MTOK, args.in[I_FFNN], XN, lane); }
    GRID_BAR();

    {
        pg8::Gemm g{XN, Wup_t, MTOK, 2 * DFF, 1024}; pg8::StaticOrder S; S.init(MTOK, 2 * DFF, G, bx);
        pg8::EpiUp E{UPG, AUXA, AUXG, args.in[I_FCW], args.in[I_FCB]};
        pg8::gemm_phase<pg8::EpiUp, pg8::StaticOrder, true, true>(lds, g, S, E);
    }
    GRID_BAR();

    {
        PHASE_IDS();
        const float* fw = args.in[I_FCW]; const float* fb = args.in[I_FCB];
        constexpr int NGRP = MTOK / 64, NV4 = DFF / 4;
        for (size_t idx = gtid; idx < (size_t)NGRP * 2 * NV4; idx += NGT) {
            const int g = (int)(idx / (2 * NV4)), rem = (int)(idx % (2 * NV4)), t = rem / NV4, c4 = (rem % NV4) * 4;
            const bool start = (g < MP / 64) ? ((g % (TP / 64)) == 0) : true;
            const float* hist = (g < MP / 64) ? nullptr : args.in[I_SFFN] + (size_t)(g - MP / 64) * 2 * DFF;
            const f32x4 z = {0.f, 0.f, 0.f, 0.f};
            const f32x4 at = *(const f32x4*)(AUXA + ((size_t)g * 4 + t) * DFF + c4), gt = *(const f32x4*)(AUXG + ((size_t)g * 2 + t) * DFF + c4);
            f32x4 am1, am2;
            const f32x4 h1 = start ? (hist ? *(const f32x4*)(hist + DFF + c4) : z) : *(const f32x4*)(AUXA + ((size_t)(g - 1) * 4 + 3) * DFF + c4);
            if (t == 0) { am1 = h1; am2 = start ? (hist ? *(const f32x4*)(hist + c4) : z) : *(const f32x4*)(AUXA + ((size_t)(g - 1) * 4 + 2) * DFF + c4); }
            else { am1 = *(const f32x4*)(AUXA + ((size_t)g * 4) * DFF + c4); am2 = h1; }
            const f32x4 w0 = *(const f32x4*)(fw + c4), w1 = *(const f32x4*)(fw + DFF + c4), w2 = *(const f32x4*)(fw + 2 * DFF + c4), bb = *(const f32x4*)(fb + c4);
            float hv[4];
#pragma unroll
            for (int e = 0; e < 4; ++e) { const float y = w0[e] * am2[e] + w1[e] * am1[e] + w2[e] * at[e] + bb[e]; hv[e] = y * sigmoidf_(y) * gt[e]; }
            v2u o; o.x = pk2(hv[0], hv[1]); o.y = pk2(hv[2], hv[3]);
            *(v2u*)(UPG + ((size_t)g * 64 + t) * DFF + c4) = o;
        }
        for (size_t idx = gtid; idx < (size_t)(NPB + NSB) * 2 * NV4; idx += NGT) {
            const int sq = (int)(idx / (2 * NV4)), rem = (int)(idx % (2 * NV4)), k = rem / NV4, c4 = (rem % NV4) * 4;
            const int g = (sq < NPB) ? (sq + 1) * (TP / 64) - 1 : MP / 64 + (sq - NPB);
            float* dst = (sq < NPB) ? out + O_FFNP + ((size_t)sq * 2 + k) * DFF + c4 : out + O_FFNS + ((size_t)(sq - NPB) * 2 + k) * DFF + c4;
            *(f32x4*)dst = *(const f32x4*)(AUXA + ((size_t)g * 4 + 2 + k) * DFF + c4);
        }
    }
    GRID_BAR();

    {
        pg8::Gemm g{UPG, Wdown_t, MTOK, 1024, DFF}; pg8::StaticOrder S; S.init(MTOK, 1024, G, bx);
        pg8::EpiRes<true> E{nullptr, nullptr, out};
        pg8::gemm_phase<pg8::EpiRes<true>, pg8::StaticOrder, true, true>(lds, g, S, E);
    }
}

extern "C" void kernel_launch(void* const* d_in, const int* in_sizes, int n_in, void* d_out, int out_size, void* d_ws, size_t ws_size, hipStream_t stream) {
    static int grid = 0;
    if (grid == 0) {
        if (n_in != 23 || in_sizes[0] != MP * DM || (size_t)out_size != O_TOTAL || ws_size < WS_END) {
            fprintf(stderr, "kernel_launch: unexpected shapes: n_in %d in0 %d out %d ws %zu; nothing launched\n", n_in, n_in > 0 ? in_sizes[0] : -1, out_size, ws_size); grid = -1; return; }
        int dev = 0, cus = 0, per_cu = 0;
        if (hipGetDevice(&dev) != hipSuccess || hipDeviceGetAttribute(&cus, hipDeviceAttributeMultiprocessorCount, dev) != hipSuccess) { grid = -1; return; }
        if (hipFuncSetAttribute((const void*)mk_fwd, hipFuncAttributeMaxDynamicSharedMemorySize, LDS_BYTES) != hipSuccess) { fprintf(stderr, "kernel_launch: hipFuncSetAttribute failed\n"); grid = -1; return; }
        if (hipOccupancyMaxActiveBlocksPerMultiprocessor(&per_cu, (const void*)mk_fwd, NWAVES * 64, LDS_BYTES) != hipSuccess || per_cu < 1) {
            fprintf(stderr, "kernel_launch: occupancy query reports %d workgroups per CU\n", per_cu); (void)hipGetLastError(); per_cu = 1; }
        grid = cus;
    }
    if (grid < 0) return;
    if (hipMemsetAsync((char*)d_ws + WS_CTL, 0, CTL_ZERO_BYTES, stream) != hipSuccess) { fprintf(stderr, "kernel_launch: hipMemsetAsync failed\n"); return; }
    Args a{};
    for (int i = 0; i < 23; ++i) a.in[i] = (const float*)d_in[i];
    a.out = (float*)d_out; a.ws = (unsigned char*)d_ws;
    void* kargs[] = {&a};
    const hipError_t e = hipLaunchCooperativeKernel((const void*)mk_fwd, dim3(grid), dim3(NWAVES * 64), kargs, LDS_BYTES, stream);
    if (e != hipSuccess) fprintf(stderr, "kernel_launch: cooperative launch failed: %s (grid %d)\n", hipGetErrorString(e), grid);
}
```

```cpp
#include <hip/hip_runtime.h>
#include <hip/hip_cooperative_groups.h>
#include <cstdio>
#include <cstdint>
namespace cg = cooperative_groups;
namespace pg8 {
#define PG8_LAS __attribute__((address_space(3)))
typedef unsigned short bf16_t;
typedef short bf16x8 __attribute__((ext_vector_type(8)));
typedef float f32x4 __attribute__((ext_vector_type(4)));
typedef unsigned u32x4 __attribute__((ext_vector_type(4)));
constexpr int BM = 256, BK = 64, HALF = 128, HTB = HALF * BK * 2  , STAGE_BYTES = 8 * HTB, NXCD = 8, WGM = 8;

__host__ __device__ __forceinline__ int lds_byte(int r, int c) { const int st = (r >> 4) * 2 + (c >> 5), rr = r & 15, cc = c & 31, ob = rr * 64 + cc * 2; return st * 1024 + (ob ^ (((ob >> 9) & 1) << 5)); }
__host__ __device__ __forceinline__ void stage_rc(int b, int& R, int& C) { const int st = b / 1024, sb = b % 1024, swz = sb ^ (((sb >> 9) & 1) << 5); R = (st >> 1) * 16 + swz / 64; C = (st & 1) * 32 + (swz % 64) / 2; }
__host__ __device__ __forceinline__ int perm32(int rho) { const int n = rho >> 4, i = rho & 15; return 8 * (i >> 2) + 4 * n + (i & 3); }

struct Unit { int pm, pn; };
struct Gemm { const bf16_t* A; const bf16_t* Bt; int M, N, K; };

struct StaticOrder {
    int nM, nN, nwg, G, c;
    __host__ __device__ void init(int M, int N, int G_, int c_) { nM = M / BM; nN = N / BM; nwg = nM * nN; G = G_; c = c_; }
    __host__ __device__ bool next(int i, Unit& u) const {
        const long L = (long)i * G + c; if (L >= nwg) return false;
        int wgid = (int)L; { const int q = nwg / NXCD, r = nwg % NXCD, xcd = wgid % NXCD, off = wgid / NXCD; wgid = (xcd < r ? xcd * (q + 1) : r * (q + 1) + (xcd - r) * q) + off; }
        const int nig = WGM * nN, gid = wgid / nig, fm = gid * WGM, gsz = (nM - fm) < WGM ? (nM - fm) : WGM;
        u.pm = fm + ((wgid % nig) % gsz); u.pn = (wgid % nig) / gsz; return true;
    }
    __device__ __forceinline__ void a_ready(const Unit&) const {}
    __device__ __forceinline__ void done(const Unit&) const {}
};


__device__ __forceinline__ unsigned cvt_pk_bf16(float lo, float hi) { unsigned r; asm volatile("v_cvt_pk_bf16_f32 %0, %1, %2" : "=v"(r) : "v"(lo), "v"(hi)); return r; }

struct EpiBf16 {
    static constexpr bool PERM = true, AFTER_DRAIN = false;
    bf16_t* O; int ldc; int split_cols; size_t split_stride;
    __device__ __forceinline__ void operator()(const f32x4 (&acc)[2][2][4][2], const Unit& u, int wr, int wc, int fr, int fq) const {
        const int row0 = u.pm * BM + wr * 64 + fr; int colt = u.pn * BM; bf16_t* base = O;
        if (split_cols) { const int t = colt / split_cols; base += (size_t)t * split_stride; colt -= t * split_cols; }
        const int col0 = colt + wc * 32 + 8 * fq;
#pragma unroll
        for (int ai = 0; ai < 2; ++ai)
#pragma unroll
            for (int m = 0; m < 4; ++m) { bf16_t* rowp = base + (size_t)(row0 + ai * HALF + m * 16) * ldc + col0;
#pragma unroll
                for (int bj = 0; bj < 2; ++bj) { const f32x4 v0 = acc[ai][bj][m][0], v1 = acc[ai][bj][m][1];
                    u32x4 w; w.x = cvt_pk_bf16(v0[0], v0[1]); w.y = cvt_pk_bf16(v0[2], v0[3]); w.z = cvt_pk_bf16(v1[0], v1[1]); w.w = cvt_pk_bf16(v1[2], v1[3]);
                    *(u32x4*)(rowp + bj * HALF) = w; } }
    }
};

struct EpiInProj {
    static constexpr bool PERM = true, AFTER_DRAIN = false;
    float* PROJ; float* U;
    __device__ __forceinline__ void operator()(const f32x4 (&acc)[2][2][4][2], const Unit& u, int wr, int wc, int fr, int fq) const {
        const int row0 = u.pm * BM + wr * 64 + fr;
        if (u.pn < 3) {
            const int col0 = u.pn * BM + wc * 32 + 8 * fq;
#pragma unroll
            for (int ai = 0; ai < 2; ++ai)
#pragma unroll
                for (int m = 0; m < 4; ++m) { float* rowp = PROJ + (size_t)(row0 + ai * HALF + m * 16) * 768 + col0;
#pragma unroll
                    for (int bj = 0; bj < 2; ++bj) { *(f32x4*)(rowp + bj * HALF) = acc[ai][bj][m][0]; *(f32x4*)(rowp + bj * HALF + 4) = acc[ai][bj][m][1]; } }
        } else {
            const int ch0 = (u.pn - 3) * 128 + 16 * wc + 4 * fq;
#pragma unroll
            for (int ai = 0; ai < 2; ++ai)
#pragma unroll
                for (int m = 0; m < 4; ++m) { float* rowp = U + (size_t)(row0 + ai * HALF + m * 16) * 512 + ch0;
#pragma unroll
                    for (int bj = 0; bj < 2; ++bj) { const f32x4 a = acc[ai][bj][m][0], g = acc[ai][bj][m][1]; f32x4 o;
#pragma unroll
                        for (int e = 0; e < 4; ++e) o[e] = a[e] * __builtin_amdgcn_rcpf(1.f + __expf(-g[e]));
                        *(f32x4*)(rowp + bj * 64) = o; } }
        }
    }
};

struct EpiUp {
    static constexpr bool PERM = true, AFTER_DRAIN = false;
    bf16_t* H; float* AUXA; float* AUXG; const float* fw; const float* fb;
    __device__ __forceinline__ void operator()(const f32x4 (&acc)[2][2][4][2], const Unit& u, int wr, int wc, int fr, int fq) const {
        const int lane = fq * 16 + fr, src1 = (lane & 48) | ((fr + 15) & 15), src2 = (lane & 48) | ((fr + 14) & 15);
        const int ch0 = u.pn * 128 + 16 * wc + 4 * fq;
#pragma unroll
        for (int bj = 0; bj < 2; ++bj) {
            const int ch = ch0 + 64 * bj;
            const f32x4 w0 = *(const f32x4*)(fw + ch), w1 = *(const f32x4*)(fw + 2816 + ch), w2 = *(const f32x4*)(fw + 2 * 2816 + ch), bb = *(const f32x4*)(fb + ch);
#pragma unroll
            for (int ai = 0; ai < 2; ++ai) {
                const int grp = 4 * u.pm + 2 * ai + wr; const size_t row0 = (size_t)u.pm * BM + ai * HALF + wr * 64 + fr;
                f32x4 hv[4];
#pragma unroll
                for (int e = 0; e < 4; ++e) {
                    float r1[4], r2[4];
#pragma unroll
                    for (int m = 0; m < 4; ++m) { r1[m] = __shfl(acc[ai][bj][m][0][e], src1); r2[m] = __shfl(acc[ai][bj][m][0][e], src2); }
#pragma unroll
                    for (int m = 0; m < 4; ++m) {
                        const float p1 = (fr >= 1) ? r1[m] : r1[m > 0 ? m - 1 : 0], p2 = (fr >= 2) ? r2[m] : r2[m > 0 ? m - 1 : 0];
                        const float y = w0[e] * p2 + w1[e] * p1 + w2[e] * acc[ai][bj][m][0][e] + bb[e];
                        hv[m][e] = y * __builtin_amdgcn_rcpf(1.f + __expf(-y)) * acc[ai][bj][m][1][e];
                    }
                }
#pragma unroll
                for (int m = 0; m < 4; ++m) if (m > 0 || fr >= 2) {
                    unsigned lo = cvt_pk_bf16(hv[m][0], hv[m][1]), hi = cvt_pk_bf16(hv[m][2], hv[m][3]);
                    typedef unsigned u32x2 __attribute__((ext_vector_type(2)));
                    *(u32x2*)(H + (row0 + 16 * m) * 2816 + ch) = (u32x2){lo, hi};
                }
                if (fr < 2) { *(f32x4*)(AUXA + ((size_t)grp * 4 + fr) * 2816 + ch) = acc[ai][bj][0][0]; *(f32x4*)(AUXG + ((size_t)grp * 2 + fr) * 2816 + ch) = acc[ai][bj][0][1]; }
                if (fr >= 14) *(f32x4*)(AUXA + ((size_t)grp * 4 + 2 + (fr - 14)) * 2816 + ch) = acc[ai][bj][3][0];
            }
        }
    }
};

struct EpiKV {
    static constexpr bool PERM = true, AFTER_DRAIN = false;
    bf16_t* Kb; bf16_t* Vb; const float* kpe_p; const float* kpe_s; const float* kpe_past; const float* gk; const float* ropec; const float* ropes;
    __device__ __forceinline__ void operator()(const f32x4 (&acc)[2][2][4][2], const Unit& u, int wr, int wc, int fr_in, int fq_in) const {
        int fr0 = fr_in, fq0 = fq_in; asm volatile("" : "+v"(fr0), "+v"(fq0));
        const int h = 2 * u.pn + (wc >> 1);
        constexpr int TP_ = 16384, MP_ = 32768, MTOK_ = 33792, TKS_ = 2112, PAST_ = 2048; constexpr size_t KSB = (size_t)2 * 8 * TP_;
#pragma unroll
        for (int ai = 0; ai < 2; ++ai)
#pragma unroll
            for (int m = 0; m < 4; ++m) {
                int fr = fr0, fq = fq0; asm volatile("" : "+v"(fr), "+v"(fq) :: "memory");
                const int r = u.pm * BM + ai * HALF + wr * 64 + m * 16 + fr;
                size_t drow; int pos; const float* kpe;
                if (r < MP_) { const int b = r / TP_, t = r % TP_; pos = t; kpe = kpe_p + (size_t)r * 32; drow = (size_t)(b * 8 + h) * TP_ + t; }
                else if (r < MTOK_) { const int rs = r - MP_, b = rs >> 6, t = rs & 63; pos = PAST_ + t; kpe = kpe_s + (size_t)rs * 32; drow = KSB + (size_t)(b * 8 + h) * TKS_ + PAST_ + t; }
                else { const int rr = r - MTOK_, b = rr / PAST_, t = rr % PAST_; pos = t; kpe = kpe_past + (size_t)rr * 32; drow = KSB + (size_t)(b * 8 + h) * TKS_ + t; }
                if (wc & 1) {
                    bf16_t* vd = Vb + drow * 64 + 8 * fq;
#pragma unroll
                    for (int bj = 0; bj < 2; ++bj) { const f32x4 v0 = acc[ai][bj][m][0], v1 = acc[ai][bj][m][1];
                        u32x4 w; w.x = cvt_pk_bf16(v0[0], v0[1]); w.y = cvt_pk_bf16(v0[2], v0[3]); w.z = cvt_pk_bf16(v1[0], v1[1]); w.w = cvt_pk_bf16(v1[2], v1[3]);
                        *(u32x4*)(vd + 32 * bj) = w; }
                } else {
                    const f32x4 pe0 = *(const f32x4*)(kpe + 8 * fq), pe1 = *(const f32x4*)(kpe + 8 * fq + 4);
                    const f32x4 pp0 = *(const f32x4*)(kpe + 8 * (fq ^ 2)), pp1 = *(const f32x4*)(kpe + 8 * (fq ^ 2) + 4);
                    float ss = 0.f;
#pragma unroll
                    for (int bj = 0; bj < 2; ++bj)
#pragma unroll
                        for (int n = 0; n < 2; ++n)
#pragma unroll
                            for (int e = 0; e < 4; ++e) ss += acc[ai][bj][m][n][e] * acc[ai][bj][m][n][e];
#pragma unroll
                    for (int e = 0; e < 4; ++e) ss += pe0[e] * pe0[e] + pe1[e] * pe1[e];
                    ss += __shfl_xor(ss, 16); ss += __shfl_xor(ss, 32);
                    const float rstd = 1.f / sqrtf(ss * (1.f / 96.f) + 1e-6f);
                    bf16_t* kd = Kb + drow * 96 + 8 * fq;
#pragma unroll
                    for (int bj = 0; bj < 2; ++bj) { const f32x4 g0 = *(const f32x4*)(gk + 32 * bj + 8 * fq), g1 = *(const f32x4*)(gk + 32 * bj + 8 * fq + 4);
                        const f32x4 v0 = acc[ai][bj][m][0] * rstd * g0, v1 = acc[ai][bj][m][1] * rstd * g1;
                        u32x4 w; w.x = cvt_pk_bf16(v0[0], v0[1]); w.y = cvt_pk_bf16(v0[2], v0[3]); w.z = cvt_pk_bf16(v1[0], v1[1]); w.w = cvt_pk_bf16(v1[2], v1[3]);
                        *(u32x4*)(kd + 32 * bj) = w; }
                    const f32x4 ge0 = *(const f32x4*)(gk + 64 + 8 * fq), ge1 = *(const f32x4*)(gk + 64 + 8 * fq + 4);
                    const f32x4 gp0 = *(const f32x4*)(gk + 64 + 8 * (fq ^ 2)), gp1 = *(const f32x4*)(gk + 64 + 8 * (fq ^ 2) + 4);
                    const float* cs = ropec + (size_t)pos * 16 + 8 * (fq & 1); const float* sn = ropes + (size_t)pos * 16 + 8 * (fq & 1);
                    const f32x4 c0 = *(const f32x4*)cs, c1 = *(const f32x4*)(cs + 4), s0 = *(const f32x4*)sn, s1 = *(const f32x4*)(sn + 4);
                    const float sg = (fq < 2) ? -1.f : 1.f;
                    const f32x4 o0 = (pe0 * ge0 * c0 + (pp0 * gp0 * s0) * sg) * rstd, o1 = (pe1 * ge1 * c1 + (pp1 * gp1 * s1) * sg) * rstd;
                    u32x4 w; w.x = cvt_pk_bf16(o0[0], o0[1]); w.y = cvt_pk_bf16(o0[2], o0[3]); w.z = cvt_pk_bf16(o1[0], o1[1]); w.w = cvt_pk_bf16(o1[2], o1[3]);
                    *(u32x4*)(kd + 64) = w;
                }
            }
    }
};

template <bool INPLACE> struct EpiRes {
    static constexpr bool PERM = true, AFTER_DRAIN = false;
    const float* xp; const float* xs; float* out;
    __device__ __forceinline__ void operator()(const f32x4 (&acc)[2][2][4][2], const Unit& u, int wr, int wc, int fr, int fq) const {
        const int row0 = u.pm * BM + wr * 64 + fr; const int col0 = u.pn * BM + wc * 32 + 8 * fq;
        const float* rbase = INPLACE ? (const float*)out : (u.pm * BM < 32768 ? xp : xs - (size_t)32768 * 1024);
#pragma unroll
        for (int ai = 0; ai < 2; ++ai)
#pragma unroll
            for (int m = 0; m < 4; ++m) { const size_t off = (size_t)(row0 + ai * HALF + m * 16) * 1024 + col0;
#pragma unroll
                for (int bj = 0; bj < 2; ++bj) { const f32x4 r0 = *(const f32x4*)(rbase + off + bj * HALF), r1 = *(const f32x4*)(rbase + off + bj * HALF + 4);
                    *(f32x4*)(out + off + bj * HALF) = r0 + acc[ai][bj][m][0]; *(f32x4*)(out + off + bj * HALF + 4) = r1 + acc[ai][bj][m][1]; } }
    }
};

template <class Epi, class Sched, bool ALIGN_EPI = false, bool SP2 = false>
__device__ __forceinline__ void gemm_phase(PG8_LAS unsigned char* lds, const Gemm g, const Sched& S, const Epi& E) {
    int tid_ = threadIdx.x; asm volatile("" : "+v"(tid_));
    const int tid = tid_, wid = __builtin_amdgcn_readfirstlane(tid >> 6), lane = tid & 63, wr = wid >> 2, wc = wid & 3, fr = lane & 15, fq = lane >> 4;
    int K_ = g.K; asm volatile("" : "+s"(K_));
    const int K = K_, nt = K / BK;
    unsigned voffA[2], voffB[2];
#pragma unroll
    for (int i = 0; i < 2; ++i) { int R, C; stage_rc(tid * 16 + i * 8192, R, C); const int Rb = Epi::PERM ? ((R & ~31) + perm32(R & 31)) : R;
        voffA[i] = (unsigned)(R * K + C) * 2u; voffB[i] = (unsigned)(Rb * K + C) * 2u; }
    const size_t kstep = (size_t)(BK * 2);
    const size_t hstep = (size_t)HALF * K * 2;
    const size_t tstep = 2 * hstep;
    const unsigned ldsw = (unsigned)wid * 1024u;
    const int aoff = lds_byte(wr * 64 + fr, fq * 8), boff = lds_byte(wc * 32 + fr, fq * 8);
#define PG8_SA(b, h) (((b) * 2 + (h)) * HTB)
#define PG8_SB(b, h) ((4 + (b) * 2 + (h)) * HTB)
#define PG8_STAGE(bufoff, gbase, voff) do { _Pragma("unroll") for (int _i = 0; _i < 2; ++_i) \
        __builtin_amdgcn_global_load_lds((const unsigned*)((const char*)(gbase) + (voff)[_i]), (PG8_LAS unsigned*)(lds + (bufoff) + ldsw + _i * 8192), 16, 0, 0); } while (0)
#define PG8_LDA(dst, b, h) do { _Pragma("unroll") for (int m = 0; m < 4; ++m) _Pragma("unroll") for (int k = 0; k < 2; ++k) dst[m][k] = *(const PG8_LAS bf16x8*)(lds + PG8_SA(b, h) + aoff + m * 2048 + k * 1024); } while (0)
#define PG8_LDB(dst, b, h) do { _Pragma("unroll") for (int n = 0; n < 2; ++n) _Pragma("unroll") for (int k = 0; k < 2; ++k) dst[n][k] = *(const PG8_LAS bf16x8*)(lds + PG8_SB(b, h) + boff + n * 2048 + k * 1024); } while (0)
#define PG8_MMA(ai, bj, At, Bt) do { __builtin_amdgcn_s_setprio(1); _Pragma("unroll") for (int m = 0; m < 4; ++m) _Pragma("unroll") for (int n = 0; n < 2; ++n) _Pragma("unroll") for (int k = 0; k < 2; ++k) \
        acc[ai][bj][m][n] = __builtin_amdgcn_mfma_f32_16x16x32_bf16(Bt[n][k], At[m][k], acc[ai][bj][m][n], 0, 0, 0); __builtin_amdgcn_s_setprio(0); } while (0)
#define PG8_WAIT_V(n) asm volatile("s_waitcnt vmcnt(" #n ")" ::: "memory")
#define PG8_WAIT_L(n) asm volatile("s_waitcnt lgkmcnt(" #n ")" ::: "memory")
#define PG8_BAR __builtin_amdgcn_s_barrier()
#define PG8_SCHED __builtin_amdgcn_sched_barrier(0)
    Unit cur, nxt; int ui = 0;
    if (!S.next(0, cur)) return;
    f32x4 acc[2][2][4][2];
#pragma unroll
    for (int a = 0; a < 2; ++a)
#pragma unroll
        for (int b = 0; b < 2; ++b)
#pragma unroll
            for (int m = 0; m < 4; ++m)
#pragma unroll
                for (int n = 0; n < 2; ++n) acc[a][b][m][n] = (f32x4){0.f, 0.f, 0.f, 0.f};
    bf16x8 At[4][2], B0[2][2], B1[2][2];
    const char* cA = (const char*)g.A + (size_t)cur.pm * tstep; const char* cB = (const char*)g.Bt + (size_t)cur.pn * tstep;
    S.a_ready(cur);
    if constexpr (SP2) {
        PG8_STAGE(PG8_SB(0, 0), cB, voffB); PG8_STAGE(PG8_SB(0, 1), cB + hstep, voffB); PG8_STAGE(PG8_SA(0, 0), cA, voffA); PG8_STAGE(PG8_SA(0, 1), cA + hstep, voffA);
        if (wr == 1) PG8_BAR;
        PG8_WAIT_V(2); PG8_BAR;
        PG8_STAGE(PG8_SB(1, 0), cB + kstep, voffB); PG8_STAGE(PG8_SA(1, 0), cA + kstep, voffA); PG8_STAGE(PG8_SB(1, 1), cB + hstep + kstep, voffB);
        PG8_WAIT_V(6); PG8_BAR;
    } else {
        PG8_STAGE(PG8_SB(0, 0), cB, voffB); PG8_STAGE(PG8_SA(0, 0), cA, voffA); PG8_STAGE(PG8_SB(0, 1), cB + hstep, voffB); PG8_STAGE(PG8_SA(0, 1), cA + hstep, voffA);
        if (wr == 1) PG8_BAR;
        PG8_WAIT_V(4); PG8_BAR;
        PG8_STAGE(PG8_SB(1, 0), cB + kstep, voffB); PG8_STAGE(PG8_SA(1, 0), cA + kstep, voffA); PG8_STAGE(PG8_SB(1, 1), cB + hstep + kstep, voffB);
        PG8_WAIT_V(6); PG8_BAR;
    }
    for (;;) {
        const bool has_next = S.next(ui + 1, nxt);
        const char* nA = has_next ? (const char*)g.A + (size_t)nxt.pm * tstep : cA; const char* nB = has_next ? (const char*)g.Bt + (size_t)nxt.pn * tstep : cB;
        for (int t = 0; t < nt; t += 2) {
            const bool last = (t == nt - 2);
            const char* a1 = cA + (size_t)(t + 1) * kstep;
            const char* a2 = last ? nA : cA + (size_t)(t + 2) * kstep; const char* b2 = last ? nB : cB + (size_t)(t + 2) * kstep;
            const char* a3 = a2 + kstep; const char* b3 = b2 + kstep;
            if (last && has_next) S.a_ready(nxt);
            if constexpr (SP2) {
            PG8_LDB(B0, 0, 0); PG8_LDB(B1, 0, 1); PG8_SCHED; PG8_LDA(At, 0, 0); PG8_STAGE(PG8_SA(1, 1), a1 + hstep, voffA);
            PG8_WAIT_V(8); PG8_WAIT_L(0); PG8_BAR; PG8_MMA(0, 0, At, B0); PG8_MMA(0, 1, At, B1); PG8_BAR; PG8_SCHED;
            PG8_LDA(At, 0, 1); PG8_STAGE(PG8_SB(0, 0), b2, voffB); PG8_STAGE(PG8_SB(0, 1), b2 + hstep, voffB); PG8_STAGE(PG8_SA(0, 0), a2, voffA);
            PG8_WAIT_V(8); PG8_WAIT_L(0); PG8_BAR; PG8_MMA(1, 0, At, B0); PG8_MMA(1, 1, At, B1); PG8_BAR; PG8_SCHED;
            PG8_LDB(B0, 1, 0); PG8_LDB(B1, 1, 1); PG8_SCHED; PG8_LDA(At, 1, 0); PG8_STAGE(PG8_SA(0, 1), a2 + hstep, voffA);
            PG8_WAIT_V(8); PG8_WAIT_L(0); PG8_BAR; PG8_MMA(0, 0, At, B0); PG8_MMA(0, 1, At, B1); PG8_BAR; PG8_SCHED;
            PG8_LDA(At, 1, 1); PG8_STAGE(PG8_SB(1, 0), b3, voffB); PG8_STAGE(PG8_SB(1, 1), b3 + hstep, voffB); PG8_STAGE(PG8_SA(1, 0), a3, voffA);
            PG8_WAIT_V(8); PG8_WAIT_L(0); PG8_BAR; PG8_MMA(1, 0, At, B0); PG8_MMA(1, 1, At, B1); PG8_BAR; PG8_SCHED;
            } else {
            PG8_LDB(B0, 0, 0); PG8_SCHED; PG8_LDA(At, 0, 0); PG8_STAGE(PG8_SA(1, 1), a1 + hstep, voffA);
            PG8_WAIT_L(8); PG8_BAR; PG8_WAIT_L(0); PG8_MMA(0, 0, At, B0); PG8_BAR; PG8_SCHED;
            PG8_LDB(B1, 0, 1); PG8_STAGE(PG8_SB(0, 0), b2, voffB);
            PG8_BAR; PG8_WAIT_L(0); PG8_MMA(0, 1, At, B1); PG8_BAR;
            PG8_LDA(At, 0, 1); PG8_STAGE(PG8_SA(0, 0), a2, voffA);
            PG8_BAR; PG8_WAIT_L(0); PG8_MMA(1, 0, At, B0); PG8_BAR; PG8_SCHED;
            PG8_STAGE(PG8_SB(0, 1), b2 + hstep, voffB);
            PG8_WAIT_V(6); PG8_BAR; PG8_MMA(1, 1, At, B1); PG8_BAR;
            PG8_LDB(B0, 1, 0); PG8_SCHED; PG8_LDA(At, 1, 0); PG8_STAGE(PG8_SA(0, 1), a2 + hstep, voffA);
            PG8_WAIT_L(8); PG8_BAR; PG8_WAIT_L(0); PG8_MMA(0, 0, At, B0); PG8_BAR; PG8_SCHED;
            PG8_LDB(B1, 1, 1); PG8_STAGE(PG8_SB(1, 0), b3, voffB);
            PG8_BAR; PG8_WAIT_L(0); PG8_MMA(0, 1, At, B1); PG8_BAR;
            PG8_LDA(At, 1, 1); PG8_STAGE(PG8_SA(1, 0), a3, voffA);
            PG8_BAR; PG8_WAIT_L(0); PG8_MMA(1, 0, At, B0); PG8_BAR; PG8_SCHED;
            PG8_STAGE(PG8_SB(1, 1), b3 + hstep, voffB);
            PG8_WAIT_V(6); PG8_BAR; PG8_MMA(1, 1, At, B1); PG8_BAR;
            }
        }
        if constexpr (ALIGN_EPI) { if (wr == 0) PG8_BAR; }
        if constexpr (!Epi::AFTER_DRAIN) { E(acc, cur, wr, wc, fr, fq); S.done(cur); }
        if (!has_next) break;
#pragma unroll
        for (int a = 0; a < 2; ++a)
#pragma unroll
            for (int b = 0; b < 2; ++b)
#pragma unroll
                for (int m = 0; m < 4; ++m)
#pragma unroll
                    for (int n = 0; n < 2; ++n) acc[a][b][m][n] = (f32x4){0.f, 0.f, 0.f, 0.f};
        cur = nxt; cA = nA; cB = nB; ++ui;
        if constexpr (ALIGN_EPI) { if (wr == 1) PG8_BAR; }
    }
    PG8_WAIT_V(0);
    if constexpr (!ALIGN_EPI) { if (wr == 0) PG8_BAR; }
    PG8_BAR;
    if constexpr (Epi::AFTER_DRAIN) { E.fused(acc, cur, wr, wc, fr, fq, lds, wid, lane); S.done(cur); }
#undef PG8_SA
#undef PG8_SB
#undef PG8_STAGE
#undef PG8_LDA
#undef PG8_LDB
#undef PG8_MMA
#undef PG8_WAIT_V
#undef PG8_WAIT_L
#undef PG8_BAR
#undef PG8_SCHED
}
}

#define LAS __attribute__((address_space(3)))
typedef unsigned short bf16;
typedef unsigned v4u __attribute__((ext_vector_type(4)));
typedef unsigned v2u __attribute__((ext_vector_type(2)));
typedef float f32x4 __attribute__((ext_vector_type(4)));
typedef float f32x16 __attribute__((ext_vector_type(16)));
typedef short bf16x8 __attribute__((ext_vector_type(8)));
typedef short s16x4 __attribute__((ext_vector_type(4)));
typedef float f32x2_t __attribute__((ext_vector_type(2)));
typedef __bf16 bf16x2_t __attribute__((ext_vector_type(2)));

constexpr int NWAVES = 8;
constexpr int DM = 1024, TP = 16384, NPB = 2, TS = 64, NSB = 16, PAST = 2048, TKS = PAST + TS;
constexpr int MP = NPB * TP, MS = NSB * TS, MTOK = MP + MS, MKV = MTOK + NSB * PAST;
constexpr int QLORA = 384, KVLORA = 256, ROPE = 32, CONVCH = 512, CONVK = 31, DFF = 2816, NH = 8, HD = 96, VD = 64;
constexpr int NIN_PAD = 1792;
constexpr float EPS = 1e-6f;
constexpr size_t O_YP = 0, O_YS = 33554432, O_CKVP = 34603008, O_KPEP = 42991616, O_CONVP = 44040192, O_FFNP = 44070912,
                 O_CKVS = 44082176, O_KPES = 44344320, O_CONVS = 44377088, O_FFNS = 44622848, O_TOTAL = 44712960;
constexpr size_t MiB = 1u << 20;
constexpr size_t WS_CTL = 0, CTL_ZERO_BYTES = 65536; constexpr int CW_BAR = 4096;
constexpr size_t WS_WIN = 1 * MiB, WS_WUQ = 5 * MiB, WS_WUKV = 6 * MiB, WS_WOUT = 7 * MiB, WS_WUP = 9 * MiB, WS_WDOWN = 20 * MiB, WS_ROPEC = 26 * MiB, WS_ROPES = 27 * MiB;
constexpr size_t WS_XN = 32 * MiB;
constexpr size_t WS_V = 32 * MiB;
constexpr size_t WS_MIX = 98 * MiB;
constexpr size_t WS_PROJ = 164 * MiB;
constexpr size_t WS_A3 = 331 * MiB;
constexpr size_t WS_CQN = 364 * MiB;
constexpr size_t WS_Q = 164 * MiB;
constexpr size_t WS_U = 164 * MiB + 100 * MiB;
constexpr size_t WS_K = 404 * MiB;
constexpr size_t WS_AUXA = 98 * MiB;
constexpr size_t WS_AUXG = 122 * MiB;
constexpr size_t WS_UPG = 280 * MiB;
constexpr size_t WS_END = 512 * MiB;
static_assert(WS_K + (size_t)(NPB * NH * TP + NSB * NH * TKS) * HD * 2 <= WS_END, "ws map");
static_assert(WS_UPG + (size_t)MTOK * DFF * 2 <= WS_END && WS_AUXA + (size_t)(MTOK / 64) * 4 * DFF * 4 <= WS_AUXG && WS_AUXG + (size_t)(MTOK / 64) * 2 * DFF * 4 <= WS_UPG, "ws map");
static_assert(WS_PROJ + (size_t)MTOK * 768 * 4 <= WS_U && WS_Q + (size_t)MTOK * 768 * 2 <= WS_U && WS_U + (size_t)MTOK * 512 * 4 <= WS_A3 && WS_A3 + (size_t)MKV * 256 * 2 <= WS_CQN && WS_CQN + (size_t)MTOK * 384 * 2 <= WS_K, "ws map");
static_assert(WS_V + (size_t)(NPB * NH * TP + NSB * NH * TKS) * VD * 2 <= WS_MIX && WS_MIX + (size_t)MTOK * 1024 * 2 <= WS_PROJ, "ws map");

constexpr int RING_BYTES = 131072;
constexpr int LDS_BYTES = 147456;

#define LDS_WAIT() asm volatile("s_waitcnt lgkmcnt(0)" ::: "memory")
__device__ __forceinline__ unsigned f2bf(float f) { unsigned u = __builtin_bit_cast(unsigned, f); return (u + 0x7fffu + ((u >> 16) & 1u)) >> 16; }
__device__ __forceinline__ unsigned pk2(float lo, float hi) { f32x2_t v = {lo, hi}; bf16x2_t b = __builtin_convertvector(v, bf16x2_t); return __builtin_bit_cast(unsigned, b); }
__device__ __forceinline__ float bflo(unsigned w) { return __uint_as_float(w << 16); }
__device__ __forceinline__ float bfhi(unsigned w) { return __uint_as_float(w & 0xffff0000u); }
__device__ __forceinline__ float wave_sum(float v) {
#pragma unroll
    for (int o = 1; o < 64; o <<= 1) v += __shfl_xor(v, o);
    return v;
}
__device__ __forceinline__ float sigmoidf_(float x) { return __builtin_amdgcn_rcpf(1.f + __expf(-x)); }

__device__ __forceinline__ int win_row(int n) {
    if (n < 672) return n;
    if (n < 1184) { const int ch = n - 672; return 768 + (ch >> 2) * 8 + (ch & 3); }
    const int ch = n - 1184; return 768 + (ch >> 2) * 8 + 4 + (ch & 3);
}
__device__ __forceinline__ int wup_row(int n) {
    if (n < 2816) return 256 * (n >> 7) + 8 * ((n & 127) >> 2) + (n & 3);
    const int ch = n - 2816; return 256 * (ch >> 7) + 8 * ((ch & 127) >> 2) + 4 + (ch & 3);
}
__device__ __forceinline__ int wukv_row(int n) {
    const int h = n >> 7, isv = (n >> 6) & 1, d = n & 63;
    return 256 * (h >> 1) + 128 * (d >> 5) + 32 * (2 * (h & 1) + isv) + (d & 31);
}
template <int RMAP>
__device__ __forceinline__ void p0_transpose_item(const float* W, int K, int N, bf16* WT, LAS float* scr, int item, int lane) {
    const int nblk = N / 32, kb = item / nblk, nb = item % nblk, k0 = 64 * kb, n0 = 32 * nb;
#pragma unroll 8
    for (int i = 0; i < 32; ++i) { const int kk = 2 * i + (lane >> 5); scr[kk * 33 + (lane & 31)] = __builtin_nontemporal_load(W + (size_t)(k0 + kk) * N + n0 + (lane & 31)); }
    LDS_WAIT(); asm volatile("" ::: "memory");
    const int c = lane & 7;
#pragma unroll
    for (int j = 0; j < 4; ++j) { const int n = (lane >> 3) + 8 * j; const LAS float* s = scr + (8 * c) * 33 + n;
        v4u o; o.x = pk2(s[0 * 33], s[1 * 33]); o.y = pk2(s[2 * 33], s[3 * 33]); o.z = pk2(s[4 * 33], s[5 * 33]); o.w = pk2(s[6 * 33], s[7 * 33]);
        const int drow = (RMAP == 1) ? win_row(n0 + n) : (RMAP == 2) ? wup_row(n0 + n) : (RMAP == 3) ? wukv_row(n0 + n) : (n0 + n);
        *(v4u*)(WT + (size_t)drow * K + k0 + 8 * c) = o; }
    LDS_WAIT(); asm volatile("" ::: "memory");
}
__device__ __forceinline__ void rms_row_to_bf16(const float* xrow, const float* g, bf16* orow, int lane) {
    const f32x4* xr = (const f32x4*)xrow + lane; const f32x4* gr = (const f32x4*)g + lane;
    f32x4 v[4]; float s = 0.f;
#pragma unroll
    for (int j = 0; j < 4; ++j) { v[j] = xr[64 * j]; s += (v[j].x * v[j].x + v[j].y * v[j].y) + (v[j].z * v[j].z + v[j].w * v[j].w); }
    const float rstd = 1.f / sqrtf(wave_sum(s) * (1.f / 1024.f) + EPS);
    v2u* o8 = (v2u*)orow + lane;
#pragma unroll
    for (int j = 0; j < 4; ++j) { const f32x4 gg = gr[64 * j]; v2u o; o.x = pk2(v[j].x * rstd * gg.x, v[j].y * rstd * gg.y); o.y = pk2(v[j].z * rstd * gg.z, v[j].w * rstd * gg.w); o8[64 * j] = o; }
}
template <int NR, class RowPtr, bool NT = false>
__device__ __forceinline__ void rms_rows_to_bf16(const RowPtr& rowptr, int m0, int stride, int mlim, const float* g, bf16* O, int lane) {
    f32x4 v[NR][4]; float ss[NR];
#pragma unroll
    for (int r = 0; r < NR; ++r) { const int m = m0 + r * stride; const float* x = rowptr(m < mlim ? m : m0);
#pragma unroll
        for (int j = 0; j < 2; ++j) {
            if (NT) { v[r][2 * j] = __builtin_nontemporal_load((const f32x4*)(x + 512 * j + 8 * lane)); v[r][2 * j + 1] = __builtin_nontemporal_load((const f32x4*)(x + 512 * j + 8 * lane + 4)); }
            else { v[r][2 * j] = *(const f32x4*)(x + 512 * j + 8 * lane); v[r][2 * j + 1] = *(const f32x4*)(x + 512 * j + 8 * lane + 4); } } }
#pragma unroll
    for (int r = 0; r < NR; ++r) { float s = 0.f;
#pragma unroll
        for (int j = 0; j < 4; ++j) s += (v[r][j].x * v[r][j].x + v[r][j].y * v[r][j].y) + (v[r][j].z * v[r][j].z + v[r][j].w * v[r][j].w);
        ss[r] = s; }
#pragma unroll
    for (int o = 1; o < 64; o <<= 1) {
#pragma unroll
        for (int r = 0; r < NR; ++r) ss[r] += __shfl_xor(ss[r], o); }
#pragma unroll
    for (int r = 0; r < NR; ++r) { const int m = m0 + r * stride; if (m < mlim) { const float rstd = 1.f / sqrtf(ss[r] * (1.f / 1024.f) + EPS);
#pragma unroll
        for (int j = 0; j < 2; ++j) { const f32x4 g0 = *(const f32x4*)(g + 512 * j + 8 * lane), g1 = *(const f32x4*)(g + 512 * j + 8 * lane + 4);
            const f32x4 a0 = v[r][2 * j] * rstd * g0, a1 = v[r][2 * j + 1] * rstd * g1; v4u a;
            a.x = pk2(a0.x, a0.y); a.y = pk2(a0.z, a0.w); a.z = pk2(a1.x, a1.y); a.w = pk2(a1.z, a1.w); *(v4u*)(O + (size_t)m * 1024 + 512 * j + 8 * lane) = a; } } }
}
__device__ __forceinline__ void sincos_acc(float ang, float& sn, float& cs) {
    const double x = (double)ang;
    const double n = __builtin_rint(x * 0.63661977236758134308);
    double r = x - n * 1.57079632679489655800e+00; r -= n * 6.12323399573676603587e-17;
    const double r2 = r * r;
    double sp = -7.6471637318198164759e-13; sp = sp * r2 + 1.6059043836821614599e-10; sp = sp * r2 - 2.5052108385441718775e-08; sp = sp * r2 + 2.7557319223985890653e-06;
    sp = sp * r2 - 1.9841269841269841270e-04; sp = sp * r2 + 8.3333333333333333333e-03; sp = sp * r2 - 1.6666666666666666667e-01; const double s = r + r * r2 * sp;
    double cp = 4.7794773323873852974e-14; cp = cp * r2 - 1.1470745597729724714e-11; cp = cp * r2 + 2.0876756987868098979e-09; cp = cp * r2 - 2.7557319223985890653e-07;
    cp = cp * r2 + 2.4801587301587301587e-05; cp = cp * r2 - 1.3888888888888888889e-03; cp = cp * r2 + 4.1666666666666666667e-02; cp = cp * r2 - 0.5; const double c = 1.0 + r2 * cp;
    const int q = ((int)n) & 3;
    const double ss = (q == 0) ? s : (q == 1) ? c : (q == 2) ? -s : -c;
    const double cc = (q == 0) ? c : (q == 1) ? -s : (q == 2) ? -c : s;
    sn = (float)ss; cs = (float)cc;
}

namespace att {
constexpr int KSLOT = 12288, VSLOT = 8192;
constexpr int LDS_K = 0, LDS_V = 2 * KSLOT, LDS_WS = LDS_V + 2 * VSLOT, LDS_END = LDS_WS + NWAVES * 32 * 4;
__device__ __forceinline__ int crow(int r, int hi) { return (r & 3) + 8 * (r >> 2) + 4 * hi; }
__device__ __forceinline__ void glds16(const void* gsrc, unsigned lds_dst) { unsigned keep;
    asm volatile("s_mov_b32 %0, m0\n\ts_mov_b32 m0, %2\n\ts_nop 0\n\tglobal_load_lds_dwordx4 %1, off\n\ts_mov_b32 m0, %0" : "=&s"(keep) : "v"(gsrc), "s"(lds_dst) : "memory"); }
typedef short v4i16_t __attribute__((ext_vector_type(4)));
__device__ __forceinline__ s16x4 vtr(const LAS char* p) { return __builtin_bit_cast(s16x4, __builtin_amdgcn_ds_read_tr16_b64_v4i16((LAS v4i16_t*)p)); }
#define MFMA32(a, b, c) __builtin_amdgcn_mfma_f32_32x32x16_bf16((a), (b), (c), 0, 0, 0)

__device__ __forceinline__ void attn_unit(LAS unsigned char* lds, const bf16* Qrows, const bf16* Kb, const bf16* Vb, bf16* Orows, int pos0, int nrows,
                                          const float* gq, const float* ropec, const float* ropes) {
    int tid = threadIdx.x; asm volatile("" : "+v"(tid)); const int lane = tid & 63, r32 = lane & 31, hi = lane >> 5; const int wid = __builtin_amdgcn_readfirstlane(tid >> 6);
    const unsigned lds0 = (unsigned)(uintptr_t)lds;
    const bool active = (wid * 32 < nrows);
    const int NT = (pos0 + nrows - 1) / 64 + 1;
    const int ntw = active ? (pos0 + wid * 32) / 64 + 1 : 0;
    LAS float* wsf = (LAS float*)(lds + LDS_WS) + wid * 32;
    const bf16* ksrc = Kb + (size_t)lane * HD + wid * 8;
    const bf16* vsrc = Vb + (size_t)(16 * (wid & 3) + (lane >> 2)) * VD + (wid >> 2) * 32 + (lane & 3) * 8;
#define ATT_DMA_K(t, slot) do { glds16(ksrc + (size_t)(t) * 64 * HD, (unsigned)__builtin_amdgcn_readfirstlane(lds0 + LDS_K + (slot) * KSLOT + wid * 1024)); \
        if (wid < 4) glds16(ksrc + (size_t)(t) * 64 * HD + 64, (unsigned)__builtin_amdgcn_readfirstlane(lds0 + LDS_K + (slot) * KSLOT + (8 + wid) * 1024)); } while (0)
#define ATT_DMA_V(t, slot) glds16(vsrc + (size_t)(t) * 64 * VD, (unsigned)__builtin_amdgcn_readfirstlane(lds0 + LDS_V + (slot) * VSLOT + wid * 1024))
    ATT_DMA_K(0, 0); if (NT > 1) ATT_DMA_K(1, 1); ATT_DMA_V(0, 0);
    bf16x8 qr[6];
#pragma unroll
    for (int d0 = 0; d0 < 6; ++d0) qr[d0] = (bf16x8){0, 0, 0, 0, 0, 0, 0, 0};
    if (active) {
        const bf16* qp = Qrows + (size_t)(32 * wid + r32) * 768 + 8 * hi;
        float qv[6][8]; float ss = 0.f;
#pragma unroll
        for (int d0 = 0; d0 < 6; ++d0) { const v4u raw = *(const v4u*)(qp + 16 * d0);
#pragma unroll
            for (int j = 0; j < 4; ++j) { qv[d0][2 * j] = bflo(raw[j]); qv[d0][2 * j + 1] = bfhi(raw[j]); }
#pragma unroll
            for (int j = 0; j < 8; ++j) ss += qv[d0][j] * qv[d0][j]; }
        ss += __shfl_xor(ss, 32);
        const float rstd = 1.f / sqrtf(ss * (1.f / 96.f) + EPS);
#pragma unroll
        for (int d0 = 0; d0 < 6; ++d0)
#pragma unroll
            for (int j = 0; j < 8; ++j) qv[d0][j] *= rstd * gq[16 * d0 + 8 * hi + j];
        const int pos = pos0 + 32 * wid + r32;
        const float* cs = ropec + (size_t)pos * 16 + 8 * hi; const float* sn = ropes + (size_t)pos * 16 + 8 * hi;
#pragma unroll
        for (int j = 0; j < 8; ++j) { const float c = cs[j], s = sn[j], p1 = qv[4][j], p2 = qv[5][j]; qv[4][j] = p1 * c - p2 * s; qv[5][j] = p2 * c + p1 * s; }
        const float qs = 0.10206207261596575f * 1.4426950408889634f;
#pragma unroll
        for (int d0 = 0; d0 < 6; ++d0) { v4u w;
#pragma unroll
            for (int j = 0; j < 4; ++j) w[j] = pk2(qv[d0][2 * j] * qs, qv[d0][2 * j + 1] * qs);
            qr[d0] = __builtin_bit_cast(bf16x8, w); }
    }
    constexpr float THR = 24.f;
    float m_run = 0.f, l_run = 0.f;
    f32x16 o[2], negm;
#pragma unroll
    for (int r = 0; r < 16; ++r) { o[0][r] = 0.f; o[1][r] = 0.f; negm[r] = 0.f; }
    const LAS char* kp0 = (const LAS char*)lds + LDS_K + hi * 1024 + r32 * 16;
    const LAS char* vp0 = (const LAS char*)lds + LDS_V + ((lane >> 4) & 1) * 32 + (lane & 3) * 8 + (4 * hi + ((lane & 15) >> 2)) * 64;
#define SBAR() __builtin_amdgcn_sched_barrier(0)
#define MX3(a, b, c) __builtin_fmaxf(__builtin_fmaxf((a), (b)), (c))
#define QK_STEP(N0, N1, KP, d0, CIN0, CIN1) do { const bf16x8 k0_ = *(const LAS bf16x8*)((KP) + (d0) * 2048), k1_ = *(const LAS bf16x8*)((KP) + (d0) * 2048 + 512); \
        N0 = MFMA32(k0_, qr[d0], CIN0); N1 = MFMA32(k1_, qr[d0], CIN1); } while (0)
#define TILE_MAX(M, C0, C1) do { float a_ = MX3(C0[0], C0[1], C1[0]), b_ = MX3(C0[2], C0[3], C1[1]); a_ = MX3(a_, C1[2], C1[3]); \
        _Pragma("unroll") for (int r = 4; r < 16; r += 4) { a_ = MX3(a_, C0[r], C0[r + 1]); b_ = MX3(b_, C0[r + 2], C0[r + 3]); a_ = MX3(a_, C1[r], C1[r + 1]); b_ = MX3(b_, C1[r + 2], C1[r + 3]); } \
        M = __builtin_fmaxf(a_, b_); } while (0)
#define SM_EXP8(C, B) do { _Pragma("unroll") for (int r = (B); r < (B) + 8; ++r) { C[r] = __builtin_amdgcn_exp2f(C[r]); rs += C[r]; } } while (0)
#define SM_PACK() do { v4u w_; \
        w_.x = pk2(c0[0], c0[1]); w_.y = pk2(c0[2], c0[3]); w_.z = pk2(c0[4], c0[5]); w_.w = pk2(c0[6], c0[7]); pa[0] = __builtin_bit_cast(bf16x8, w_); \
        w_.x = pk2(c0[8], c0[9]); w_.y = pk2(c0[10], c0[11]); w_.z = pk2(c0[12], c0[13]); w_.w = pk2(c0[14], c0[15]); pa[1] = __builtin_bit_cast(bf16x8, w_); \
        w_.x = pk2(c1[0], c1[1]); w_.y = pk2(c1[2], c1[3]); w_.z = pk2(c1[4], c1[5]); w_.w = pk2(c1[6], c1[7]); pa[2] = __builtin_bit_cast(bf16x8, w_); \
        w_.x = pk2(c1[8], c1[9]); w_.y = pk2(c1[10], c1[11]); w_.z = pk2(c1[12], c1[13]); w_.w = pk2(c1[14], c1[15]); pa[3] = __builtin_bit_cast(bf16x8, w_); \
        l_run += rs; } while (0)
#define FIX_REF() do { if (__any(mxc > THR)) { const float mx_ = __builtin_fmaxf(mxc, __shfl_xor(mxc, 32)); const float dl_ = __builtin_fmaxf(mx_, 0.f); \
        m_run += dl_; _Pragma("unroll") for (int r = 0; r < 16; ++r) { c0[r] -= dl_; c1[r] -= dl_; negm[r] = -m_run; } \
        const float f_ = __builtin_amdgcn_exp2f(-dl_); l_run *= f_; if (hi == 0) wsf[r32] = f_; LDS_WAIT(); \
        _Pragma("unroll") for (int r = 0; r < 16; ++r) { const float a_ = wsf[crow(r, hi)]; o[0][r] *= a_; o[1][r] *= a_; } LDS_WAIT(); } } while (0)
#define PV_TILE(VP) do { _Pragma("unroll") for (int s_ = 0; s_ < 4; ++s_) _Pragma("unroll") for (int dh = 0; dh < 2; ++dh) { \
        const s16x4 lo_ = vtr((VP) + dh * 4096 + s_ * 1024), h4_ = vtr((VP) + dh * 4096 + s_ * 1024 + 512); \
        const bf16x8 vf_ = (bf16x8){lo_[0], lo_[1], lo_[2], lo_[3], h4_[0], h4_[1], h4_[2], h4_[3]}; \
        o[dh] = MFMA32(pa[s_], vf_, o[dh]); } } while (0)
    asm volatile("s_waitcnt vmcnt(0)" ::: "memory");
    __builtin_amdgcn_s_barrier();
    f32x16 c0 = negm, c1 = negm; float mxc = 0.f;
    if (ntw > 0) {
#pragma unroll
        for (int d0 = 0; d0 < 6; ++d0) QK_STEP(c0, c1, kp0, d0, c0, c1);
        TILE_MAX(mxc, c0, c1);
    }
    for (int t = 0; t < NT; ++t) {
        asm volatile("s_waitcnt vmcnt(0)" ::: "memory");
        __builtin_amdgcn_s_barrier();
        if (t + 2 < NT) ATT_DMA_K(t + 2, t & 1);
        if (t + 1 < NT) ATT_DMA_V(t + 1, (t + 1) & 1);
        if (t + 1 < ntw) {
            FIX_REF();
            const LAS char* kp = kp0 + ((t + 1) & 1) * KSLOT; const LAS char* vp = vp0 + (t & 1) * VSLOT;
            f32x16 n0, n1; bf16x8 pa[4]; float rs = 0.f;
#define KLD(A0, A1, d0) do { A0 = *(const LAS bf16x8*)(kp + (d0) * 2048); A1 = *(const LAS bf16x8*)(kp + (d0) * 2048 + 512); } while (0)
#define VLD(F, s_, dh) do { const s16x4 lo_ = vtr(vp + (dh) * 4096 + (s_) * 1024), h4_ = vtr(vp + (dh) * 4096 + (s_) * 1024 + 512); \
        F = (bf16x8){lo_[0], lo_[1], lo_[2], lo_[3], h4_[0], h4_[1], h4_[2], h4_[3]}; } while (0)
            bf16x8 ka0, ka1, kb0, kb1, va0, va1, vb0, vb1;
            SBAR();
            KLD(ka0, ka1, 0); KLD(kb0, kb1, 1); SM_EXP8(c0, 0); SBAR();
            n0 = MFMA32(ka0, qr[0], negm); n1 = MFMA32(ka1, qr[0], negm); KLD(ka0, ka1, 2); SM_EXP8(c0, 8); SBAR();
            n0 = MFMA32(kb0, qr[1], n0); n1 = MFMA32(kb1, qr[1], n1); KLD(kb0, kb1, 3); SM_EXP8(c1, 0); SBAR();
            n0 = MFMA32(ka0, qr[2], n0); n1 = MFMA32(ka1, qr[2], n1); KLD(ka0, ka1, 4); SM_EXP8(c1, 8); SBAR();
            n0 = MFMA32(kb0, qr[3], n0); n1 = MFMA32(kb1, qr[3], n1); KLD(kb0, kb1, 5); SM_PACK(); SBAR();
            n0 = MFMA32(ka0, qr[4], n0); n1 = MFMA32(ka1, qr[4], n1); VLD(va0, 0, 0); VLD(va1, 0, 1); SBAR();
            n0 = MFMA32(kb0, qr[5], n0); n1 = MFMA32(kb1, qr[5], n1); VLD(vb0, 1, 0); VLD(vb1, 1, 1); SBAR();
            o[0] = MFMA32(pa[0], va0, o[0]); o[1] = MFMA32(pa[0], va1, o[1]); VLD(va0, 2, 0); VLD(va1, 2, 1); SBAR();
            o[0] = MFMA32(pa[1], vb0, o[0]); o[1] = MFMA32(pa[1], vb1, o[1]); VLD(vb0, 3, 0); VLD(vb1, 3, 1); SBAR();
            o[0] = MFMA32(pa[2], va0, o[0]); o[1] = MFMA32(pa[2], va1, o[1]); SBAR();
            o[0] = MFMA32(pa[3], vb0, o[0]); o[1] = MFMA32(pa[3], vb1, o[1]);
#undef KLD
#undef VLD
            c0 = n0; c1 = n1;
            TILE_MAX(mxc, c0, c1);
        } else if (t < ntw) {
            FIX_REF();
            const LAS char* vp = vp0 + (t & 1) * VSLOT;
            bf16x8 pa[4]; float rs = 0.f;
            SM_EXP8(c0, 0); SM_EXP8(c0, 8); SM_EXP8(c1, 0); SM_EXP8(c1, 8); SM_PACK();
            PV_TILE(vp);
        }
    }
#undef SBAR
#undef MX3
#undef QK_STEP
#undef TILE_MAX
#undef SM_EXP8
#undef SM_PACK
#undef FIX_REF
#undef PV_TILE
    if (active) {
        l_run += __shfl_xor(l_run, 32);
        if (hi == 0) wsf[r32] = l_run;
        LDS_WAIT();
        int r32b = r32, hib = hi; asm volatile("" : "+v"(r32b), "+v"(hib));
        bf16* op = Orows + (size_t)(32 * wid + 4 * hib) * 1024 + r32b;
        const LAS float* lw = wsf + 4 * hib;
#pragma unroll
        for (int r = 0; r < 16; ++r) { const int q = (r & 3) + 8 * (r >> 2); const float inv = __builtin_amdgcn_rcpf(lw[q]);
            op[(size_t)q * 1024] = (bf16)f2bf(o[0][r] * inv); op[(size_t)q * 1024 + 32] = (bf16)f2bf(o[1][r] * inv); }
    }
    asm volatile("s_waitcnt lgkmcnt(0)" ::: "memory");
    __builtin_amdgcn_s_barrier();
#undef ATT_DMA_K
#undef ATT_DMA_V
}
}

#define XB_TMO      128
#define XB_XCNT(j)  (256  + 64 * (j))
#define XB_XSUB(j)  (1280 + 64 * (j))
#define XB_XGEN(j)  (2304 + 64 * (j))
#define XB_TOP      3328
#define XB_TOPGEN   3392
#define XCD_BAR_WORDS 3456
#define XB_SPIN_CAP (1u << 18)

__device__ __forceinline__ unsigned xb_ld(unsigned* p)              { return __hip_atomic_load(p, __ATOMIC_RELAXED, __HIP_MEMORY_SCOPE_AGENT); }
__device__ __forceinline__ unsigned xb_add(unsigned* p, unsigned v) { return __hip_atomic_fetch_add(p, v, __ATOMIC_RELAXED, __HIP_MEMORY_SCOPE_AGENT); }
__device__ __forceinline__ unsigned xb_xcc_id() { return (unsigned)__builtin_amdgcn_s_getreg((3 << 11) | 20) & 0xFu; }
#define XB_SPIN(cond, bar) do { unsigned _sp = 0; while (cond) { __builtin_amdgcn_s_sleep(1); \
    if ((++_sp & 255u) == 0u) { if (xb_ld(&(bar)[XB_TMO])) break; if (_sp > XB_SPIN_CAP) { atomicAdd(&(bar)[XB_TMO], 1u); break; } } } } while (0)

struct XcdBarrier {
    unsigned* bar; unsigned x;
    volatile LAS unsigned* st;
};

__device__ __forceinline__ XcdBarrier xcd_barrier_post(unsigned* bar, volatile LAS unsigned* st) {
    XcdBarrier b; b.bar = bar; b.x = xb_xcc_id(); b.st = st;
    if (threadIdx.x == 0) (void)xb_add(&bar[XB_XCNT(b.x)], 1u);
    return b;
}
__device__ __forceinline__ void xcd_barrier_complete(unsigned* bar, unsigned x, unsigned& nloc, unsigned& nx) {
    const unsigned G = gridDim.x * gridDim.y * gridDim.z;
    unsigned sum, cnt, mine, sp = 0u;
    for (;;) {
        sum = 0u; cnt = 0u; mine = 0u;
#pragma unroll
        for (unsigned j = 0; j < 16; ++j) { const unsigned c = xb_ld(&bar[XB_XCNT(j)]); sum += c; cnt += (c > 0u) ? 1u : 0u; mine = (j == x) ? c : mine; }
        if (sum == G) break;
        __builtin_amdgcn_s_sleep(1);
        if ((++sp & 255u) == 0u) { if (xb_ld(&bar[XB_TMO])) break; if (sp > XB_SPIN_CAP) { atomicAdd(&bar[XB_TMO], 1u); break; } }
    }
    nloc = mine > 0u ? mine : 1u; nx = cnt > 0u ? cnt : 1u;
}

__device__ __forceinline__ void xcd_barrier(const XcdBarrier& b) {
    asm volatile("s_waitcnt vmcnt(0)" ::: "memory");
    __syncthreads();
    if (threadIdx.x == 0) {
        unsigned* bar = b.bar;
        __builtin_amdgcn_s_waitcnt(0);
        unsigned nloc = b.st[0], nx = b.st[1];
        if (nloc == 0u) { xcd_barrier_complete(bar, b.x, nloc, nx); b.st[0] = nloc; b.st[1] = nx; }
        const unsigned old = xb_add(&bar[XB_XSUB(b.x)], 1u);
        const unsigned gen = old / nloc;
        if (old + 1u == (gen + 1u) * nloc) {
            __builtin_amdgcn_fence(__ATOMIC_RELEASE, "agent");
            asm volatile("s_waitcnt vmcnt(0)" ::: "memory");
            const unsigned og = xb_add(&bar[XB_TOP], 1u);
            const unsigned tg = og / nx;
            if (og + 1u == (tg + 1u) * nx) xb_add(&bar[XB_TOPGEN], 1u);
            else XB_SPIN(xb_ld(&bar[XB_TOPGEN]) == tg, bar);
            __builtin_amdgcn_fence(__ATOMIC_ACQUIRE, "agent");
            xb_add(&bar[XB_XGEN(b.x)], 1u);
            asm volatile("s_waitcnt vmcnt(0)" ::: "memory");
        } else {
            XB_SPIN(xb_ld(&bar[XB_XGEN(b.x)]) == gen, bar);
            __builtin_amdgcn_fence(__ATOMIC_ACQUIRE, "agent");
            asm volatile("s_waitcnt vmcnt(0)" ::: "memory");
        }
    }
    __syncthreads();
}

struct Args { const float* in[23]; float* out; unsigned char* ws; };
enum { I_XP = 0, I_XS, I_CKV, I_KPE, I_SCONV, I_SFFN, I_ATTN_NORM, I_WIN, I_QNORM, I_WUQ, I_KVNORM, I_WUKV, I_QKNQ, I_QKNK, I_CONVW, I_CONVB, I_CONVN, I_WOUT, I_FFNN, I_WUP, I_FCW, I_FCB, I_WDOWN };

__global__ void __launch_bounds__(NWAVES * 64, 2) mk_fwd(Args args) {
    extern __shared__ __attribute__((aligned(16))) unsigned char lds_raw[];
    LAS unsigned char* lds = (LAS unsigned char*)lds_raw;
    const int G = gridDim.x, bx = blockIdx.x;
    const int vcu = (G % 8 == 0) ? (bx % 8) * (G / 8) + bx / 8 : bx;
    const int NGW = G * NWAVES; const size_t NGT = (size_t)G * NWAVES * 64;
#define PHASE_IDS() int tid = threadIdx.x; asm volatile("" : "+v"(tid)); const int lane = tid & 63, wave = __builtin_amdgcn_readfirstlane(tid >> 6); \
    const int gw = vcu * NWAVES + wave; const size_t gtid = (size_t)bx * (NWAVES * 64) + tid; (void)lane; (void)gw; (void)gtid
    unsigned char* ws = args.ws; float* out = args.out;
    volatile LAS unsigned* bar_st = (volatile LAS unsigned*)(lds + RING_BYTES + 512);
    if (threadIdx.x < 4) bar_st[threadIdx.x] = 0u;
    __syncthreads();
    const XcdBarrier xbar = xcd_barrier_post((unsigned*)(ws + WS_CTL) + CW_BAR, bar_st);
#define GRID_BAR() xcd_barrier(xbar)
    const float* xp = args.in[I_XP]; const float* xs = args.in[I_XS];
    bf16* Win_t = (bf16*)(ws + WS_WIN); bf16* Wuq_t = (bf16*)(ws + WS_WUQ); bf16* Wukv_t = (bf16*)(ws + WS_WUKV); bf16* Wout_t = (bf16*)(ws + WS_WOUT);
    bf16* Wup_t = (bf16*)(ws + WS_WUP); bf16* Wdown_t = (bf16*)(ws + WS_WDOWN);
    float* ropec = (float*)(ws + WS_ROPEC); float* ropes = (float*)(ws + WS_ROPES);
    bf16* XN = (bf16*)(ws + WS_XN); bf16* Vbuf = (bf16*)(ws + WS_V); bf16* MIX = (bf16*)(ws + WS_MIX); float* PROJ = (float*)(ws + WS_PROJ);
    bf16* A3 = (bf16*)(ws + WS_A3); bf16* CQN = (bf16*)(ws + WS_CQN); bf16* Qb = (bf16*)(ws + WS_Q);
    float* U = (float*)(ws + WS_U); bf16* Kbuf = (bf16*)(ws + WS_K); float* AUXA = (float*)(ws + WS_AUXA); float* AUXG = (float*)(ws + WS_AUXG); bf16* UPG = (bf16*)(ws + WS_UPG);

    {
        PHASE_IDS();
        LAS float* scr = (LAS float*)(lds + wave * 16384);
        constexpr int I_IN = (1024 / 64) * (1696 / 32), I_UQ = (384 / 64) * (768 / 32), I_UKV = (256 / 64) * (1024 / 32), I_OUT = (1024 / 64) * (1024 / 32),
                      I_UP = (1024 / 64) * (5632 / 32), I_DOWN = (2816 / 64) * (1024 / 32);
        constexpr int NITEMS = I_IN + I_UQ + I_UKV + I_OUT + I_UP + I_DOWN;
        for (int it = gw; it < NITEMS; it += NGW) {
            int r = it;
            if (r < I_IN) { p0_transpose_item<1>(args.in[I_WIN], 1024, 1696, Win_t, scr, r, lane); continue; } r -= I_IN;
            if (r < I_UQ) { p0_transpose_item<0>(args.in[I_WUQ], 384, 768, Wuq_t, scr, r, lane); continue; } r -= I_UQ;
            if (r < I_UKV) { p0_transpose_item<3>(args.in[I_WUKV], 256, 1024, Wukv_t, scr, r, lane); continue; } r -= I_UKV;
            if (r < I_OUT) { p0_transpose_item<0>(args.in[I_WOUT], 1024, 1024, Wout_t, scr, r, lane); continue; } r -= I_OUT;
            if (r < I_UP) { p0_transpose_item<2>(args.in[I_WUP], 1024, 5632, Wup_t, scr, r, lane); continue; } r -= I_UP;
            p0_transpose_item<0>(args.in[I_WDOWN], 2816, 1024, Wdown_t, scr, r, lane);
        }
        for (size_t i = gtid; i < (size_t)96 * 1024 / 8; i += NGT) ((v4u*)(Win_t + (size_t)672 * 1024))[i] = (v4u){0u, 0u, 0u, 0u};
        { auto xrow = [=](int m) { return m < MP ? xp + (size_t)m * DM : xs + (size_t)(m - MP) * DM; };
          for (int m = gw; m < MTOK; m += 4 * NGW) rms_rows_to_bf16<4, decltype(xrow), true>(xrow, m, NGW, MTOK, args.in[I_ATTN_NORM], XN, lane); }
        { const float* c = args.in[I_CKV]; bf16* dst = A3 + (size_t)MTOK * KVLORA;
          for (size_t i = gtid; i < (size_t)NSB * PAST * KVLORA / 8; i += NGT) { const f32x4 a = __builtin_nontemporal_load((const f32x4*)c + 2 * i), b = __builtin_nontemporal_load((const f32x4*)c + 2 * i + 1);
              v4u o; o.x = pk2(a.x, a.y); o.y = pk2(a.z, a.w); o.z = pk2(b.x, b.y); o.w = pk2(b.z, b.w); ((v4u*)dst)[i] = o; } }
        for (size_t i = gtid; i < (size_t)TP * 16; i += NGT) { const int pos = (int)(i >> 4), k = (int)(i & 15);
            double inv = 1.0; for (int j = 0; j < k; ++j) inv *= 0.56234132519034908039;
            const float ang = (float)pos * (float)inv; float sn, cs; sincos_acc(ang, sn, cs); ropec[i] = cs; ropes[i] = sn; }
    }
    GRID_BAR();

    {
        pg8::Gemm g{XN, Win_t, MTOK, NIN_PAD, 1024}; pg8::StaticOrder S; S.init(MTOK, NIN_PAD, G, bx);
        pg8::EpiInProj E{PROJ, U};
        pg8::gemm_phase<pg8::EpiInProj, pg8::StaticOrder, true, true>(lds, g, S, E);
    }
    GRID_BAR();

    {
        PHASE_IDS();
        const float* qn = args.in[I_QNORM]; const float* kvn = args.in[I_KVNORM];
        const f32x4 z4 = {0.f, 0.f, 0.f, 0.f};
        const bool lq = lane < 48, lk = lane < 32, lp = lane < 8;
        const f32x4 gq0 = lq ? *(const f32x4*)(qn + 8 * lane) : z4, gq1 = lq ? *(const f32x4*)(qn + 8 * lane + 4) : z4;
        const f32x4 gk0 = lk ? *(const f32x4*)(kvn + 8 * lane) : z4, gk1 = lk ? *(const f32x4*)(kvn + 8 * lane + 4) : z4;
        constexpr int P2R = 4;
        for (int mA = gw; mA < MTOK; mA += P2R * NGW) {
            f32x4 q0[P2R], q1[P2R], k0[P2R], k1[P2R], pe[P2R];
#pragma unroll
            for (int rr = 0; rr < P2R; ++rr) { const int mr = mA + rr * NGW; const float* pr = PROJ + (size_t)(mr < MTOK ? mr : mA) * 768;
                q0[rr] = lq ? __builtin_nontemporal_load((const f32x4*)(pr + 8 * lane)) : z4; q1[rr] = lq ? __builtin_nontemporal_load((const f32x4*)(pr + 8 * lane + 4)) : z4;
                k0[rr] = lk ? __builtin_nontemporal_load((const f32x4*)(pr + 384 + 8 * lane)) : z4; k1[rr] = lk ? __builtin_nontemporal_load((const f32x4*)(pr + 384 + 8 * lane + 4)) : z4;
                pe[rr] = lp ? *(const f32x4*)(pr + 640 + 4 * lane) : z4; }
#pragma unroll
            for (int rr = 0; rr < P2R; ++rr) {
                const int m = (mA + rr * NGW < MTOK) ? mA + rr * NGW : mA;
                const f32x4 a0 = q0[rr], a1 = q1[rr], b0 = k0[rr], b1 = k1[rr];
                const float s = (a0.x * a0.x + a0.y * a0.y) + (a0.z * a0.z + a0.w * a0.w) + (a1.x * a1.x + a1.y * a1.y) + (a1.z * a1.z + a1.w * a1.w);
                const float s2 = (b0.x * b0.x + b0.y * b0.y) + (b0.z * b0.z + b0.w * b0.w) + (b1.x * b1.x + b1.y * b1.y) + (b1.z * b1.z + b1.w * b1.w);
                const float rq = 1.f / sqrtf(wave_sum(s) * (1.f / 384.f) + EPS), rk = 1.f / sqrtf(wave_sum(s2) * (1.f / 256.f) + EPS);
                if (lq) { const f32x4 y0 = a0 * rq * gq0, y1 = a1 * rq * gq1; v4u o; o.x = pk2(y0.x, y0.y); o.y = pk2(y0.z, y0.w); o.z = pk2(y1.x, y1.y); o.w = pk2(y1.z, y1.w);
                    *(v4u*)(CQN + (size_t)m * QLORA + 8 * lane) = o; }
                if (lk) { const f32x4 y0 = b0 * rk * gk0, y1 = b1 * rk * gk1;
                    float* ock = (m < MP) ? out + O_CKVP + (size_t)m * KVLORA : out + O_CKVS + (size_t)(m - MP) * KVLORA;
                    *(f32x4*)(ock + 8 * lane) = y0; *(f32x4*)(ock + 8 * lane + 4) = y1;
                    v4u o; o.x = pk2(y0.x, y0.y); o.y = pk2(y0.z, y0.w); o.z = pk2(y1.x, y1.y); o.w = pk2(y1.z, y1.w);
                    *(v4u*)(A3 + (size_t)m * KVLORA + 8 * lane) = o; }
                if (lp) { float* okp = (m < MP) ? out + O_KPEP + (size_t)m * ROPE : out + O_KPES + (size_t)(m - MP) * ROPE; *(f32x4*)(okp + 4 * lane) = pe[rr]; }
            }
        }
        for (int r = gw; r < (NPB + NSB) * 30; r += NGW) {
            const int sq = r / 30, i = r % 30;
            const float* src; float* dst;
            if (sq < NPB) { src = U + (size_t)(sq * TP + TP - 30 + i) * CONVCH; dst = out + O_CONVP + (size_t)(sq * 30 + i) * CONVCH; }
            else { const int b = sq - NPB; src = U + (size_t)(MP + b * TS + TS - 30 + i) * CONVCH; dst = out + O_CONVS + (size_t)(b * 30 + i) * CONVCH; }
#pragma unroll
            for (int j = 0; j < 2; ++j) ((f32x4*)dst)[64 * j + lane] = ((const f32x4*)src)[64 * j + lane];
        }
    }
    GRID_BAR();

    {
        { pg8::Gemm g{CQN, Wuq_t, MTOK, 768, 384}; pg8::StaticOrder S; S.init(MTOK, 768, G, (G == 256) ? (bx + 240) % 256 : bx);
          pg8::EpiBf16 E{Qb, 768, 0, 0};
          pg8::gemm_phase<pg8::EpiBf16, pg8::StaticOrder, true, true>(lds, g, S, E); }
        { pg8::Gemm g{A3, Wukv_t, MKV, 1024, 256}; pg8::StaticOrder S; S.init(MKV, 1024, G, bx);
          pg8::EpiKV E{Kbuf, Vbuf, out + O_KPEP, out + O_KPES, args.in[I_KPE], args.in[I_QKNK], ropec, ropes};
          pg8::gemm_phase<pg8::EpiKV, pg8::StaticOrder, true, true>(lds, g, S, E); }
    }
    GRID_BAR();

    {
        const float* gq = args.in[I_QKNQ];
        if (G == 256) {
            const int bh = vcu >> 4, s = vcu & 15;
            const int b = bh >> 3, h = bh & 7;
            for (int i = 0; i < 4; ++i) {
                const int qb = (i == 0) ? 63 - s : (i == 1) ? 32 + s : (i == 2) ? 31 - s : s;
                const size_t row0 = (size_t)b * TP + (size_t)qb * 256;
                att::attn_unit(lds, Qb + row0 * 768 + h * HD, Kbuf + (size_t)bh * TP * HD, Vbuf + (size_t)bh * TP * VD, MIX + row0 * 1024 + h * VD, qb * 256, 256, gq, ropec, ropes);
            }
            if (vcu < NSB * NH) {
                const int sb = vcu >> 3, sh = vcu & 7;
                const size_t row0 = (size_t)MP + (size_t)sb * TS;
                att::attn_unit(lds, Qb + row0 * 768 + sh * HD, Kbuf + ((size_t)NPB * NH * TP + (size_t)vcu * TKS) * HD, Vbuf + ((size_t)NPB * NH * TP + (size_t)vcu * TKS) * VD,
                               MIX + row0 * 1024 + sh * VD, PAST, TS, gq, ropec, ropes);
            }
        } else {
            for (int u = vcu; u < NPB * NH * 64 + NSB * NH; u += G) {
                if (u < NPB * NH * 64) { const int bh = u >> 6, qb = u & 63, b = bh >> 3, h = bh & 7; const size_t row0 = (size_t)b * TP + (size_t)qb * 256;
                    att::attn_unit(lds, Qb + row0 * 768 + h * HD, Kbuf + (size_t)bh * TP * HD, Vbuf + (size_t)bh * TP * VD, MIX + row0 * 1024 + h * VD, qb * 256, 256, gq, ropec, ropes); }
                else { const int v = u - NPB * NH * 64; const int sb = v >> 3, sh = v & 7; const size_t row0 = (size_t)MP + (size_t)sb * TS;
                    att::attn_unit(lds, Qb + row0 * 768 + sh * HD, Kbuf + ((size_t)NPB * NH * TP + (size_t)v * TKS) * HD, Vbuf + ((size_t)NPB * NH * TP + (size_t)v * TKS) * VD,
                                   MIX + row0 * 1024 + sh * VD, PAST, TS, gq, ropec, ropes); }
            }
        }
        __syncthreads();
        {
            PHASE_IDS();
            const int c = tid;
            float w[CONVK];
#pragma unroll
            for (int k = 0; k < CONVK; ++k) w[k] = args.in[I_CONVW][k * CONVCH + c];
            const float bias = args.in[I_CONVB][c], gn = args.in[I_CONVN][c];
            LAS float* red = (LAS float*)lds;
            LAS float* rsd = red + 128;
            constexpr int TB = 16, NITEM = NPB * (TP / TB) + NSB * (TS / TB);
            static_assert(NITEM == 2112, "conv item deal");
            const int nmine = (vcu >= 128 || G != 256) ? 11 : (vcu < 64 ? 6 : 5);
            for (int k = 0; k < (G == 256 ? nmine : (NITEM + G - 1) / G); ++k) {
                const int it = (G != 256) ? vcu + k * G : (vcu >= 128 ? (vcu - 128) * 11 + k : 1408 + vcu + 128 * k);
                if (it >= NITEM) break;
                const float* ubase; const float* hist; size_t mrow0; int t0;
                if (it < NPB * (TP / TB)) { const int b = it / (TP / TB); t0 = (it % (TP / TB)) * TB; mrow0 = (size_t)b * TP; hist = nullptr; }
                else { const int j = it - NPB * (TP / TB); const int b = j / (TS / TB); t0 = (j % (TS / TB)) * TB; mrow0 = (size_t)MP + (size_t)b * TS; hist = args.in[I_SCONV] + (size_t)b * 30 * CONVCH; }
                ubase = U + mrow0 * CONVCH;
                float win[TB + 30];
#pragma unroll
                for (int i = 0; i < TB + 30; ++i) { const int t = t0 - 30 + i;
                    win[i] = (t >= 0) ? ubase[(size_t)t * CONVCH + c] : (hist ? hist[(30 + t) * CONVCH + c] : 0.f); }
                float y[TB];
#pragma unroll
                for (int j = 0; j < TB; ++j) { float a = bias;
#pragma unroll
                    for (int k = 0; k < CONVK; ++k) a += w[k] * win[j + k];
                    y[j] = a; }
                float z8[8], z4[4], z2[2], z1;
                { const bool up = (lane & 32) != 0;
#pragma unroll
                  for (int j = 0; j < 8; ++j) { const float lo = y[j] * y[j], hi = y[j + 8] * y[j + 8]; const float keep = up ? hi : lo, send = up ? lo : hi; z8[j] = keep + __shfl_xor(send, 32); } }
                { const bool up = (lane & 16) != 0;
#pragma unroll
                  for (int j = 0; j < 4; ++j) { const float keep = up ? z8[j + 4] : z8[j], send = up ? z8[j] : z8[j + 4]; z4[j] = keep + __shfl_xor(send, 16); } }
                { const bool up = (lane & 8) != 0;
#pragma unroll
                  for (int j = 0; j < 2; ++j) { const float keep = up ? z4[j + 2] : z4[j], send = up ? z4[j] : z4[j + 2]; z2[j] = keep + __shfl_xor(send, 8); } }
                { const bool up = (lane & 4) != 0; const float keep = up ? z2[1] : z2[0], send = up ? z2[0] : z2[1]; z1 = keep + __shfl_xor(send, 4); }
                z1 += __shfl_xor(z1, 2); z1 += __shfl_xor(z1, 1);
                if ((lane & 3) == 0) red[wave * 16 + (lane >> 2)] = z1;
                __syncthreads();
                if (tid < 16) { float tot = 0.f;
#pragma unroll
                    for (int w8 = 0; w8 < 8; ++w8) tot += red[w8 * 16 + tid];
                    rsd[tid] = 1.f / sqrtf(tot * (1.f / 512.f) + EPS); }
                __syncthreads();
#pragma unroll
                for (int j = 0; j < TB; ++j) { const float v = y[j] * rsd[j] * gn;
                    MIX[(mrow0 + t0 + j) * 1024 + 512 + c] = (bf16)f2bf(v * __builtin_amdgcn_rcpf(1.f + __expf(-v))); }
            }
        }
    }
    GRID_BAR();

    {
        pg8::Gemm g{MIX, Wout_t, MTOK, 1024, 1024}; pg8::StaticOrder S; S.init(MTOK, 1024, G, bx);
        pg8::EpiRes<false> E{xp, xs, out};
        pg8::gemm_phase<pg8::EpiRes<false>, pg8::StaticOrder, true, true>(lds, g, S, E);
    }
    GRID_BAR();

    { PHASE_IDS(); auto orow = [=](int m) { return (const float*)out + (size_t)m * DM; };
      for (int m = gw; m < MTOK; m += 4 * NGW) rms_rows_to_bf16<4, decltype(orow), true>(orow, m, NGW, MTOK, args.in[I_FFNN], XN, lane); }
    GRID_BAR();

    {
        pg8::Gemm g{XN, Wup_t, MTOK, 2 * DFF, 1024}; pg8::StaticOrder S; S.init(MTOK, 2 * DFF, G, bx);
        pg8::EpiUp E{UPG, AUXA, AUXG, args.in[I_FCW], args.in[I_FCB]};
        pg8::gemm_phase<pg8::EpiUp, pg8::StaticOrder, true, true>(lds, g, S, E);
    }
    GRID_BAR();

    {
        PHASE_IDS();
        const float* fw = args.in[I_FCW]; const float* fb = args.in[I_FCB];
        constexpr int NGRP = MTOK / 64, NV4 = DFF / 4;
        for (size_t idx = gtid; idx < (size_t)NGRP * 2 * NV4; idx += NGT) {
            const int g = (int)(idx / (2 * NV4)), rem = (int)(idx % (2 * NV4)), t = rem / NV4, c4 = (rem % NV4) * 4;
            const bool start = (g < MP / 64) ? ((g % (TP / 64)) == 0) : true;
            const float* hist = (g < MP / 64) ? nullptr : args.in[I_SFFN] + (size_t)(g - MP / 64) * 2 * DFF;
            const f32x4 z = {0.f, 0.f, 0.f, 0.f};
            const f32x4 at = *(const f32x4*)(AUXA + ((size_t)g * 4 + t) * DFF + c4), gt = *(const f32x4*)(AUXG + ((size_t)g * 2 + t) * DFF + c4);
            f32x4 am1, am2;
            const f32x4 h1 = start ? (hist ? *(const f32x4*)(hist + DFF + c4) : z) : *(const f32x4*)(AUXA + ((size_t)(g - 1) * 4 + 3) * DFF + c4);
            if (t == 0) { am1 = h1; am2 = start ? (hist ? *(const f32x4*)(hist + c4) : z) : *(const f32x4*)(AUXA + ((size_t)(g - 1) * 4 + 2) * DFF + c4); }
            else { am1 = *(const f32x4*)(AUXA + ((size_t)g * 4) * DFF + c4); am2 = h1; }
            const f32x4 w0 = *(const f32x4*)(fw + c4), w1 = *(const f32x4*)(fw + DFF + c4), w2 = *(const f32x4*)(fw + 2 * DFF + c4), bb = *(const f32x4*)(fb + c4);
            float hv[4];
#pragma unroll
            for (int e = 0; e < 4; ++e) { const float y = w0[e] * am2[e] + w1[e] * am1[e] + w2[e] * at[e] + bb[e]; hv[e] = y * sigmoidf_(y) * gt[e]; }
            v2u o; o.x = pk2(hv[0], hv[1]); o.y = pk2(hv[2], hv[3]);
            *(v2u*)(UPG + ((size_t)g * 64 + t) * DFF + c4) = o;
        }
        for (size_t idx = gtid; idx < (size_t)(NPB + NSB) * 2 * NV4; idx += NGT) {
            const int sq = (int)(idx / (2 * NV4)), rem = (int)(idx % (2 * NV4)), k = rem / NV4, c4 = (rem % NV4) * 4;
            const int g = (sq < NPB) ? (sq + 1) * (TP / 64) - 1 : MP / 64 + (sq - NPB);
            float* dst = (sq < NPB) ? out + O_FFNP + ((size_t)sq * 2 + k) * DFF + c4 : out + O_FFNS + ((size_t)(sq - NPB) * 2 + k) * DFF + c4;
            *(f32x4*)dst = *(const f32x4*)(AUXA + ((size_t)g * 4 + 2 + k) * DFF + c4);
        }
    }
    GRID_BAR();

    {
        pg8::Gemm g{UPG, Wdown_t, MTOK, 1024, DFF}; pg8::StaticOrder S; S.init(MTOK, 1024, G, bx);
        pg8::EpiRes<true> E{nullptr, nullptr, out};
        pg8::gemm_phase<pg8::EpiRes<true>, pg8::StaticOrder, true, true>(lds, g, S, E);
    }
}

extern "C" void kernel_launch(void* const* d_in, const int* in_sizes, int n_in, void* d_out, int out_size, void* d_ws, size_t ws_size, hipStream_t stream) {
    static int grid = 0;
    if (grid == 0) {
        if (n_in != 23 || in_sizes[0] != MP * DM || (size_t)out_size != O_TOTAL || ws_size < WS_END) {
            fprintf(stderr, "kernel_launch: unexpected shapes: n_in %d in0 %d out %d ws %zu; nothing launched\n", n_in, n_in > 0 ? in_sizes[0] : -1, out_size, ws_size); grid = -1; return; }
        int dev = 0, cus = 0, per_cu = 0;
        if (hipGetDevice(&dev) != hipSuccess || hipDeviceGetAttribute(&cus, hipDeviceAttributeMultiprocessorCount, dev) != hipSuccess) { grid = -1; return; }
        if (hipFuncSetAttribute((const void*)mk_fwd, hipFuncAttributeMaxDynamicSharedMemorySize, LDS_BYTES) != hipSuccess) { fprintf(stderr, "kernel_launch: hipFuncSetAttribute failed\n"); grid = -1; return; }
        if (hipOccupancyMaxActiveBlocksPerMultiprocessor(&per_cu, (const void*)mk_fwd, NWAVES * 64, LDS_BYTES) != hipSuccess || per_cu < 1) {
            fprintf(stderr, "kernel_launch: occupancy query reports %d workgroups per CU\n", per_cu); (void)hipGetLastError(); per_cu = 1; }
        grid = cus;
    }
    if (grid < 0) return;
    if (hipMemsetAsync((char*)d_ws + WS_CTL, 0, CTL_ZERO_BYTES, stream) != hipSuccess) { fprintf(stderr, "kernel_launch: hipMemsetAsync failed\n"); return; }
    Args a{};
    for (int i = 0; i < 23; ++i) a.in[i] = (const float*)d_in[i];
    a.out = (float*)d_out; a.ws = (unsigned char*)d_ws;
    void* kargs[] = {&a};
    const hipError_t e = hipLaunchCooperativeKernel((const void*)mk_fwd, dim3(grid), dim3(NWAVES * 64), kargs, LDS_BYTES, stream);
    if (e != hipSuccess) fprintf(stderr, "kernel_launch: cooperative launch failed: %s (grid %d)\n", hipGetErrorString(e), grid);
}
```
